# Optimizing an MI355X kernel written in HIP

```python
import jax, jax.numpy as jnp
from jax import lax
import numpy as np

D_MODEL = 1024
BATCH = 8
SEQ = 4096
DEPTH = 2

HEAD_DIM = 64
N_HEADS_FOX = 6
N_HEADS_SB = 6
N_HEADS_DSA = 4
N_IDX_HEADS = 4
IDX_DIM = 64
TOPK_MAX = 256
D_FF = 2816
ROPE_THETA = 500000.0
ROT_DIM = HEAD_DIM // 4
Q_BLOCK = 128
EPS = 1e-6
N_BRANCHES = 3

W_FOX = N_HEADS_FOX * HEAD_DIM
W_SB = N_HEADS_SB * HEAD_DIM
W_DSA = N_HEADS_DSA * HEAD_DIM
IN_SPLITS = (W_FOX, W_FOX, W_FOX, N_HEADS_FOX,
             W_SB, W_SB, W_SB,
             W_DSA, W_DSA, W_DSA,
             N_IDX_HEADS * IDX_DIM, IDX_DIM, N_IDX_HEADS,
             D_MODEL, D_MODEL, D_MODEL)
N_IN = sum(IN_SPLITS)

kernel_name = "hybrid_fox_stickbreak_dsa_macaron"


def _rmsnorm(x, g):
    x32 = x.astype(jnp.float32)
    y = x32 * lax.rsqrt(jnp.mean(x32 * x32, axis=-1, keepdims=True) + EPS)
    return (y * g.astype(jnp.float32)).astype(x.dtype)


def _rope_partial(x, positions):
    half = ROT_DIM // 2
    inv_freq = jnp.power(ROPE_THETA, -jnp.arange(half, dtype=jnp.float32) * 2.0 / ROT_DIM)
    ang = positions.astype(jnp.float32)[..., None] * inv_freq
    cos = jnp.cos(ang)[:, :, None, :]
    sin = jnp.sin(ang)[:, :, None, :]
    x32 = x.astype(jnp.float32)
    x1 = x32[..., :half]
    x2 = x32[..., half:ROT_DIM]
    out = jnp.concatenate([x1 * cos - x2 * sin, x2 * cos + x1 * sin, x32[..., ROT_DIM:]], axis=-1)
    return out.astype(x.dtype)


def _swiglu(h, w_gate, w_up, w_down):
    a = jnp.einsum('bsd,df->bsf', h, w_gate)
    u = jnp.einsum('bsd,df->bsf', h, w_up)
    return jnp.einsum('bsf,fd->bsd', jax.nn.silu(a) * u, w_down)


def _to_blocks(a):
    b, s = a.shape[:2]
    a = a.reshape((b, s // Q_BLOCK, Q_BLOCK) + a.shape[2:])
    return jnp.moveaxis(a, 1, 0)


def _from_blocks(a):
    a = jnp.moveaxis(a, 0, 1)
    return a.reshape((a.shape[0], a.shape[1] * a.shape[2]) + a.shape[3:])


def _query_pos_blocks(s):
    return jnp.arange(s).reshape(s // Q_BLOCK, Q_BLOCK)


def _forgetting_attention(q, k, v, log_f):
    s_len, dh = q.shape[1], q.shape[-1]
    scale = dh ** -0.5
    cum = jnp.cumsum(log_f, axis=1)
    cum_k = jnp.transpose(cum, (0, 2, 1))
    kpos = jnp.arange(s_len)

    def block(args):
        qb, cq, tq = args
        logits = jnp.einsum('bqhd,bkhd->bhqk', qb, k, preferred_element_type=jnp.float32) * scale
        logits = logits + jnp.transpose(cq, (0, 2, 1))[..., :, None] - cum_k[..., None, :]
        causal = kpos[None, :] <= tq[:, None]
        p = jax.nn.softmax(jnp.where(causal, logits, -jnp.inf), axis=-1)
        return jnp.einsum('bhqk,bkhd->bqhd', p.astype(v.dtype), v)

    out = lax.map(block, (_to_blocks(q), _to_blocks(cum), _query_pos_blocks(s_len)))
    return _from_blocks(out)


def _stick_breaking_attention(q, k, v):
    s_len, dh = q.shape[1], q.shape[-1]
    scale = dh ** -0.5
    kpos = jnp.arange(s_len)

    def block(args):
        qb, tq = args
        z = jnp.einsum('bqhd,bkhd->bhqk', qb, k, preferred_element_type=jnp.float32) * scale
        strict = kpos[None, :] < tq[:, None]
        log_one_minus = jnp.where(strict, jax.nn.log_sigmoid(-z), 0.0)
        suffix = lax.cumsum(log_one_minus, axis=3, reverse=True) - log_one_minus
        log_a = jax.nn.log_sigmoid(z) + suffix
        a = jnp.where(strict, jnp.exp(log_a), 0.0)
        return jnp.einsum('bhqk,bkhd->bqhd', a.astype(v.dtype), v)

    out = lax.map(block, (_to_blocks(q), _query_pos_blocks(s_len)))
    return _from_blocks(out)


def _dsa_attention(q, k, v, q_idx, k_idx, w_idx, topk):
    s_len, dh = q.shape[1], q.shape[-1]
    scale = dh ** -0.5
    idx_scale = IDX_DIM ** -0.5
    w_scale = N_IDX_HEADS ** -0.5
    kpos = jnp.arange(s_len)
    gather = jax.vmap(lambda tb, ib: tb[ib])

    def block(args):
        qb, qib, wib, tq = args
        dots = jnp.einsum('bqhd,bkd->bqhk', qib, k_idx, preferred_element_type=jnp.float32) * idx_scale
        score = jnp.einsum('bqh,bqhk->bqk', wib.astype(jnp.float32) * w_scale, jax.nn.relu(dots))
        causal = kpos[None, :] <= tq[:, None]
        score = jnp.where(causal[None], score, -jnp.inf)
        _, sel = lax.top_k(score, topk)
        valid = sel <= tq[None, :, None]
        k_sel = gather(k, sel)
        v_sel = gather(v, sel)
        logits = jnp.einsum('bqhd,bqkhd->bhqk', qb, k_sel, preferred_element_type=jnp.float32) * scale
        p = jax.nn.softmax(jnp.where(valid[:, None], logits, -jnp.inf), axis=-1)
        return jnp.einsum('bhqk,bqkhd->bqhd', p.astype(v.dtype), v_sel)

    out = lax.map(block, (_to_blocks(q), _to_blocks(q_idx), _to_blocks(w_idx), _query_pos_blocks(s_len)))
    return _from_blocks(out)


def _hybrid_mixer(h, positions, w_in, b_forget, b_gates, qn_f, kn_f, qn_s, kn_s, qn_c, kn_c,
                  w_br_f, w_br_s, w_br_c, w_out, topk):
    b, s, _ = h.shape
    offs = np.cumsum(IN_SPLITS)[:-1].tolist()
    z = jnp.einsum('bsd,dn->bsn', h, w_in)
    (qf, kf, vf, ff, qs, ks, vs, qc, kc, vc, qi, ki, wi, ga, gb, gc) = jnp.split(z, offs, axis=-1)

    def heads(t):
        return t.reshape(b, s, -1, HEAD_DIM)

    log_f = jax.nn.log_sigmoid(ff.astype(jnp.float32) + b_forget.astype(jnp.float32))
    o_f = _forgetting_attention(_rmsnorm(heads(qf), qn_f), _rmsnorm(heads(kf), kn_f), heads(vf), log_f)
    o_s = _stick_breaking_attention(_rmsnorm(heads(qs), qn_s), _rmsnorm(heads(ks), kn_s), heads(vs))
    q_c = _rope_partial(_rmsnorm(heads(qc), qn_c), positions)
    k_c = _rope_partial(_rmsnorm(heads(kc), kn_c), positions)
    q_i = _rope_partial(qi.reshape(b, s, N_IDX_HEADS, IDX_DIM), positions)
    k_i = _rope_partial(ki[:, :, None, :], positions)[:, :, 0]
    o_c = _dsa_attention(q_c, k_c, heads(vc), q_i, k_i, wi, topk)

    br_f = jnp.einsum('bsm,md->bsd', o_f.reshape(b, s, W_FOX), w_br_f)
    br_s = jnp.einsum('bsm,md->bsd', o_s.reshape(b, s, W_SB), w_br_s)
    br_c = jnp.einsum('bsm,md->bsd', o_c.reshape(b, s, W_DSA), w_br_c)
    merged = (jax.nn.sigmoid(ga + b_gates[0]) * br_f
              + jax.nn.sigmoid(gb + b_gates[1]) * br_s
              + jax.nn.sigmoid(gc + b_gates[2]) * br_c)
    return jnp.einsum('bsd,de->bse', merged, w_out)


def setup_inputs(seed: int = 0) -> dict:
    key = jax.random.key(seed)
    ks = jax.random.split(key, 24)
    f32 = jnp.float32

    def w(k, shape, fan_in):
        return jax.random.normal(k, shape, f32) * (fan_in ** -0.5)

    def gain(k, shape):
        return 1.0 + 0.02 * jax.random.normal(k, shape, f32)

    return {
        "x": jax.random.normal(ks[0], (BATCH, SEQ, D_MODEL), f32),
        "positions": jnp.broadcast_to(jnp.arange(SEQ, dtype=jnp.int32)[None, :], (BATCH, SEQ)),
        "ffn1_norm": gain(ks[1], (DEPTH, D_MODEL)),
        "ffn1_w_gate": w(ks[2], (DEPTH, D_MODEL, D_FF), D_MODEL),
        "ffn1_w_up": w(ks[3], (DEPTH, D_MODEL, D_FF), D_MODEL),
        "ffn1_w_down": w(ks[4], (DEPTH, D_FF, D_MODEL), D_FF),
        "mix_norm": gain(ks[5], (DEPTH, D_MODEL)),
        "w_in": w(ks[6], (DEPTH, D_MODEL, N_IN), D_MODEL),
        "b_forget": 1.0 + 3.0 * jax.random.uniform(ks[7], (DEPTH, N_HEADS_FOX), f32),
        "b_gates": 0.02 * jax.random.normal(ks[8], (DEPTH, N_BRANCHES, D_MODEL), f32),
        "q_norm_fox": gain(ks[9], (DEPTH, HEAD_DIM)),
        "k_norm_fox": gain(ks[10], (DEPTH, HEAD_DIM)),
        "q_norm_sb": gain(ks[11], (DEPTH, HEAD_DIM)),
        "k_norm_sb": gain(ks[12], (DEPTH, HEAD_DIM)),
        "q_norm_dsa": gain(ks[13], (DEPTH, HEAD_DIM)),
        "k_norm_dsa": gain(ks[14], (DEPTH, HEAD_DIM)),
        "w_branch_fox": w(ks[15], (DEPTH, W_FOX, D_MODEL), W_FOX),
        "w_branch_sb": w(ks[16], (DEPTH, W_SB, D_MODEL), W_SB),
        "w_branch_dsa": w(ks[17], (DEPTH, W_DSA, D_MODEL), W_DSA),
        "w_out": w(ks[18], (DEPTH, D_MODEL, D_MODEL), D_MODEL),
        "ffn2_norm": gain(ks[19], (DEPTH, D_MODEL)),
        "ffn2_w_gate": w(ks[20], (DEPTH, D_MODEL, D_FF), D_MODEL),
        "ffn2_w_up": w(ks[21], (DEPTH, D_MODEL, D_FF), D_MODEL),
        "ffn2_w_down": w(ks[22], (DEPTH, D_FF, D_MODEL), D_FF),
    }


def reference(x, positions, ffn1_norm, ffn1_w_gate, ffn1_w_up, ffn1_w_down, mix_norm, w_in,
              b_forget, b_gates, q_norm_fox, k_norm_fox, q_norm_sb, k_norm_sb, q_norm_dsa, k_norm_dsa,
              w_branch_fox, w_branch_sb, w_branch_dsa, w_out, ffn2_norm, ffn2_w_gate, ffn2_w_up,
              ffn2_w_down):
    topk = min(TOPK_MAX, x.shape[1] // 4)
    for l in range(DEPTH):
        x = x + 0.5 * _swiglu(_rmsnorm(x, ffn1_norm[l]), ffn1_w_gate[l], ffn1_w_up[l], ffn1_w_down[l])
        x = x + _hybrid_mixer(_rmsnorm(x, mix_norm[l]), positions, w_in[l], b_forget[l], b_gates[l],
                              q_norm_fox[l], k_norm_fox[l], q_norm_sb[l], k_norm_sb[l],
                              q_norm_dsa[l], k_norm_dsa[l], w_branch_fox[l], w_branch_sb[l],
                              w_branch_dsa[l], w_out[l], topk)
        x = x + 0.5 * _swiglu(_rmsnorm(x, ffn2_norm[l]), ffn2_w_gate[l], ffn2_w_up[l], ffn2_w_down[l])
    return x
```

```cpp
#include <hip/hip_runtime.h>
#include <cstdio>
#include <cstdint>
#include <cmath>

#define LAS __attribute__((address_space(3)))
#define GAS __attribute__((address_space(1)))
typedef unsigned short bf16;
typedef short bf16x8 __attribute__((ext_vector_type(8)));
typedef short s16x4 __attribute__((ext_vector_type(4)));
typedef short v4i16_t __attribute__((ext_vector_type(4)));
typedef float f32x4 __attribute__((ext_vector_type(4)));
typedef float f32x2 __attribute__((ext_vector_type(2)));
typedef float f32x16 __attribute__((ext_vector_type(16)));
typedef unsigned u32x4 __attribute__((ext_vector_type(4)));
typedef unsigned u32x2 __attribute__((ext_vector_type(2)));
typedef __bf16 bf16x2_t __attribute__((ext_vector_type(2)));
typedef GAS unsigned gu32;

constexpr int BATCH = 8, SEQ = 4096, DM = 1024, M = BATCH * SEQ, DFF = 2816, NIN = 6474, DEPTH = 2;
constexpr int ACTP = 2304;
constexpr int NWIN = 3584;
constexpr float EPS = 1e-6f;
constexpr float LOG2E = 1.4426950408889634f;
constexpr float C2 = 0.125f * LOG2E;
constexpr int SL_FQ = 0, SL_SQ = 6, SL_CQ = 12, SL_FK = 16, SL_SK = 22, SL_CK = 28, SL_FV = 32, SL_SV = 38, SL_CV = 44, SL_IQ = 48, SL_IK = 52, SL_MISC = 53;
constexpr int KV_FK = 0, KV_SK = 6, KV_CK = 12, KV_FV = 16, KV_SV = 22, KV_CV = 28, KV_IK = 32, KV_SLOTS = 33, A_IQ = 32;
constexpr int SL_MERGED = 16;

constexpr size_t MiB = 1u << 20;
constexpr size_t WS_CTL = 0, CTL_BYTES = 1 * MiB;
constexpr size_t W_GU = 0, W_D = 11 * MiB, W_IN = 33 * MiB / 2  , W_G = 47 * MiB / 2  , W_BR = 59 * MiB / 2  , W_OUT = 63 * MiB / 2  ,
                 W_GU2 = 67 * MiB / 2  , W_D2 = 89 * MiB / 2  , W_LAYER = 50 * MiB;
constexpr size_t WS_W = 1 * MiB;
constexpr size_t WS_XB = 51 * MiB;
constexpr size_t WS_SSP = 115 * MiB;
constexpr size_t WS_LOGF = 117 * MiB;
constexpr size_t WS_WI = 118 * MiB;
constexpr size_t WS_PAR = 118 * MiB + 512 * 1024;
constexpr size_t WS_POS = 118 * MiB + 576 * 1024;
constexpr size_t WS_MASK = 119 * MiB;
constexpr size_t WS_GATES = 135 * MiB;
constexpr size_t WS_ACT = 231 * MiB;
constexpr size_t WS_KVH = 375 * MiB;
constexpr size_t WS_END = 507 * MiB;
static_assert(WS_ACT + (size_t)M * ACTP * 2 == WS_KVH && WS_KVH + (size_t)KV_SLOTS * M * 128 == WS_END, "ws map");
constexpr int CW_BAR = 4096, CW_Q = 8192;
#ifndef PROBE
#define PROBE 0
#endif
#ifndef SELP
#define SELP 0
#endif
#ifndef EPIP
#define EPIP 0
#endif

constexpr int RING_BYTES = 131072;
constexpr int LDS_BYTES = 163840;
constexpr int MISC_OFF = LDS_BYTES - 1024;

__device__ __forceinline__ unsigned cvtpk(float lo, float hi) { f32x2 v = {lo, hi}; bf16x2_t b = __builtin_convertvector(v, bf16x2_t); return __builtin_bit_cast(unsigned, b); }
__device__ __forceinline__ float bf2f(unsigned short h) { return __uint_as_float((unsigned)h << 16); }
__device__ __forceinline__ float bflo(unsigned w) { return __uint_as_float(w << 16); }
__device__ __forceinline__ float bfhi(unsigned w) { return __uint_as_float(w & 0xffff0000u); }
#define VM_WAIT() asm volatile("s_waitcnt vmcnt(0)" ::: "memory")
#ifndef AOFF
#define AOFF 4
#endif
#define ALIGN_LOOP() asm volatile(".p2alignl 6, 0xBF800000\n\t.rept " KSTR(AOFF) "\n\ts_nop 0\n\t.endr")
#ifndef KOFF
#define KOFF 8
#endif
#define ALIGN_LOOP_K() asm volatile(".p2alignl 6, 0xBF800000\n\t.rept " KSTR(KOFF) "\n\ts_nop 0\n\t.endr")
#define KSTR_(x) #x
#define KSTR(x) KSTR_(x)
#define LOCAL_F(name, val) float name = (val); asm volatile("" : "+v"(name))
#define LOCAL_U(name, val) unsigned name = (val); asm volatile("" : "+v"(name))
#define LOCAL_I(name, val) int name = (val); asm volatile("" : "+v"(name))
constexpr int TIDMAP_OFF = 163840 - 1024 + 256;
__device__ __forceinline__ int otid() {
    extern __shared__ __attribute__((aligned(16))) unsigned char lds_raw[];
    const unsigned hw = (unsigned)__builtin_amdgcn_s_getreg((5 << 11) | 4);
    const int w = __builtin_amdgcn_readfirstlane(((volatile LAS int*)((LAS unsigned char*)lds_raw + TIDMAP_OFF))[hw]);
    int lane; asm volatile("v_mbcnt_lo_u32_b32 %0, -1, 0\n\tv_mbcnt_hi_u32_b32 %0, -1, %0" : "=v"(lane));
    return (w << 6) | lane;
}
constexpr int ARGTAB_OFF = 163840 - 1024 + 512;
__device__ __forceinline__ const float* arg_in(int i) {
    extern __shared__ __attribute__((aligned(16))) unsigned char lds_raw[];
    const volatile LAS unsigned* p = (const volatile LAS unsigned*)((LAS unsigned char*)lds_raw + ARGTAB_OFF) + 2 * i;
    const unsigned lo = (unsigned)__builtin_amdgcn_readfirstlane((int)p[0]), hi = (unsigned)__builtin_amdgcn_readfirstlane((int)p[1]);
    return (const float*)(((unsigned long long)hi << 32) | lo);
}
#define RLX_AGENT __ATOMIC_RELAXED, __HIP_MEMORY_SCOPE_AGENT

namespace pg8 {
constexpr int BM = 256, BK = 64, HALF = 128, HTB = HALF * BK * 2, STAGE_BYTES = 8 * HTB, NXCD = 8, WGM = 8;
__device__ __forceinline__ int lds_byte(int r, int c) { const int st = (r >> 4) * 2 + (c >> 5), rr = r & 15, cc = c & 31, ob = rr * 64 + cc * 2; return st * 1024 + (ob ^ (((ob >> 9) & 1) << 5)); }
__device__ __forceinline__ void stage_rc(int b, int& R, int& C) { const int st = b / 1024, sb = b % 1024, swz = sb ^ (((sb >> 9) & 1) << 5); R = (st >> 1) * 16 + swz / 64; C = (st & 1) * 32 + (swz % 64) / 2; }
__device__ __forceinline__ int perm32(int rho) { const int n = rho >> 4, i = rho & 15; return 8 * (i >> 2) + 4 * n + (i & 3); }

struct GUnit { unsigned a, b, lda, ldb; int nt, pm, pn, mode, ui; };

struct TileOrder {
    int nM, nN, nwg, G, c;
    __device__ void init(int nM_, int nN_, int G_, int c_) { nM = nM_; nN = nN_; nwg = nM * nN; G = G_; c = c_; }
    __device__ bool tile(int i, int& pm, int& pn) const {
        const long L = (long)i * G + c; if (L >= nwg) return false;
        int wgid = (int)L; { const int q = nwg / NXCD, r = nwg % NXCD, xcd = wgid % NXCD, off = wgid / NXCD; wgid = (xcd < r ? xcd * (q + 1) : r * (q + 1) + (xcd - r) * q) + off; }
        const int nig = WGM * nN, gid = wgid / nig, fm = gid * WGM, gsz = (nM - fm) < WGM ? (nM - fm) : WGM;
        pm = fm + ((wgid % nig) % gsz); pn = (wgid % nig) / gsz; return true;
    }
};

template <class Epi, class Sched>
__device__ __forceinline__ void gemm_phase(LAS unsigned char* lds, const unsigned char* wsb, const Sched& S, const Epi& E) {
    int tid = otid();
    const int wid = __builtin_amdgcn_readfirstlane(tid >> 6), lane = tid & 63, wr = wid >> 2, wc = wid & 3, fr = lane & 15, fq = lane >> 4;
    unsigned RA[2], RB[2], CC[2];
#pragma unroll
    for (int i = 0; i < 2; ++i) { int R, C; stage_rc(tid * 16 + i * 8192, R, C); RA[i] = (unsigned)R; RB[i] = (unsigned)((R & ~31) + perm32(R & 31)); CC[i] = (unsigned)(C * 2); }
    const unsigned kstep = BK * 2;
    const unsigned ldsw = (unsigned)wid * 1024u;
    const int aoff = lds_byte(wr * 64 + fr, fq * 8), boff = lds_byte(wc * 32 + fr, fq * 8);
#define PG8_SA(b, h) (((b) * 2 + (h)) * HTB)
#define PG8_SB(b, h) ((4 + (b) * 2 + (h)) * HTB)
#define PG8_STAGE(bufoff, soff, RR, ld) do { _Pragma("unroll") for (int _i = 0; _i < 2; ++_i) { const unsigned _o = (soff) + RR[_i] * (ld) + CC[_i]; \
        __builtin_amdgcn_global_load_lds((const unsigned*)(wsb + _o), (LAS unsigned*)(lds + (bufoff) + ldsw + _i * 8192), 16, 0, 0); } } while (0)
#define PG8_LDA(dst, b, h) do { _Pragma("unroll") for (int m = 0; m < 4; ++m) _Pragma("unroll") for (int k = 0; k < 2; ++k) dst[m][k] = *(const LAS bf16x8*)(lds + PG8_SA(b, h) + aoff + m * 2048 + k * 1024); } while (0)
#define PG8_LDB(dst, b, h) do { _Pragma("unroll") for (int n = 0; n < 2; ++n) _Pragma("unroll") for (int k = 0; k < 2; ++k) dst[n][k] = *(const LAS bf16x8*)(lds + PG8_SB(b, h) + boff + n * 2048 + k * 1024); } while (0)
#define PG8_MMA(ai, bj, At, Bt) do { __builtin_amdgcn_s_setprio(1); _Pragma("unroll") for (int m = 0; m < 4; ++m) _Pragma("unroll") for (int n = 0; n < 2; ++n) _Pragma("unroll") for (int k = 0; k < 2; ++k) \
        acc[ai][bj][m][n] = __builtin_amdgcn_mfma_f32_16x16x32_bf16(Bt[n][k], At[m][k], acc[ai][bj][m][n], 0, 0, 0); __builtin_amdgcn_s_setprio(0); } while (0)
#define PG8_WAIT_V(n) asm volatile("s_waitcnt vmcnt(" #n ")" ::: "memory")
#define PG8_WAIT_L(n) asm volatile("s_waitcnt lgkmcnt(" #n ")" ::: "memory")
#define PG8_BAR __builtin_amdgcn_s_barrier()
#define PG8_SCHED __builtin_amdgcn_sched_barrier(0)
    GUnit cur, nxt; int ui = 0;
    if (!S.get(0, cur)) return;
    f32x4 acc[2][2][4][2];
#pragma unroll
    for (int a = 0; a < 2; ++a)
#pragma unroll
        for (int b = 0; b < 2; ++b)
#pragma unroll
            for (int m = 0; m < 4; ++m)
#pragma unroll
                for (int n = 0; n < 2; ++n) acc[a][b][m][n] = (f32x4){0.f, 0.f, 0.f, 0.f};
    bf16x8 At[4][2], B0[2][2], B1[2][2];
    {
        const unsigned cA = cur.a, cB = cur.b, hA = HALF * cur.lda, hB = HALF * cur.ldb;
        PG8_STAGE(PG8_SB(0, 0), cB, RB, cur.ldb); PG8_STAGE(PG8_SB(0, 1), cB + hB, RB, cur.ldb); PG8_STAGE(PG8_SA(0, 0), cA, RA, cur.lda); PG8_STAGE(PG8_SA(0, 1), cA + hA, RA, cur.lda);
        if (wr == 1) PG8_BAR;
        PG8_WAIT_V(2); PG8_BAR;
        PG8_STAGE(PG8_SB(1, 0), cB + kstep, RB, cur.ldb); PG8_STAGE(PG8_SA(1, 0), cA + kstep, RA, cur.lda); PG8_STAGE(PG8_SB(1, 1), cB + hB + kstep, RB, cur.ldb);
        PG8_WAIT_V(6); PG8_BAR;
    }
    for (;;) {
        const bool has_next = S.get(ui + 1, nxt);
        if (!has_next) { nxt = cur; }
        const unsigned cA = cur.a, cB = cur.b, lda = cur.lda, hA = HALF * cur.lda;
        const int nt = cur.nt;
        for (int t = 0; t < nt; t += 2) {
            ALIGN_LOOP_K();
            const bool last = (t == nt - 2);
            const unsigned a1 = cA + (unsigned)(t + 1) * kstep;
            const unsigned a2 = last ? nxt.a : cA + (unsigned)(t + 2) * kstep, b2 = last ? nxt.b : cB + (unsigned)(t + 2) * kstep;
            const unsigned a3 = a2 + kstep, b3 = b2 + kstep;
            const unsigned lda2 = last ? nxt.lda : cur.lda, ldb2 = last ? nxt.ldb : cur.ldb, hA2 = HALF * lda2, hB2 = HALF * ldb2;
            PG8_LDB(B0, 0, 0); PG8_LDB(B1, 0, 1); PG8_SCHED; PG8_LDA(At, 0, 0); PG8_STAGE(PG8_SA(1, 1), a1 + hA, RA, lda);
            PG8_WAIT_V(8); PG8_WAIT_L(0); PG8_BAR; PG8_MMA(0, 0, At, B0); PG8_MMA(0, 1, At, B1); PG8_BAR; PG8_SCHED;
            PG8_LDA(At, 0, 1); PG8_STAGE(PG8_SB(0, 0), b2, RB, ldb2); PG8_STAGE(PG8_SB(0, 1), b2 + hB2, RB, ldb2); PG8_STAGE(PG8_SA(0, 0), a2, RA, lda2);
            PG8_WAIT_V(8); PG8_WAIT_L(0); PG8_BAR; PG8_MMA(1, 0, At, B0); PG8_MMA(1, 1, At, B1); PG8_BAR; PG8_SCHED;
            PG8_LDB(B0, 1, 0); PG8_LDB(B1, 1, 1); PG8_SCHED; PG8_LDA(At, 1, 0); PG8_STAGE(PG8_SA(0, 1), a2 + hA2, RA, lda2);
            PG8_WAIT_V(8); PG8_WAIT_L(0); PG8_BAR; PG8_MMA(0, 0, At, B0); PG8_MMA(0, 1, At, B1); PG8_BAR; PG8_SCHED;
            PG8_LDA(At, 1, 1); PG8_STAGE(PG8_SB(1, 0), b3, RB, ldb2); PG8_STAGE(PG8_SB(1, 1), b3 + hB2, RB, ldb2); PG8_STAGE(PG8_SA(1, 0), a3, RA, lda2);
            PG8_WAIT_V(8); PG8_WAIT_L(0); PG8_BAR; PG8_MMA(1, 0, At, B0); PG8_MMA(1, 1, At, B1); PG8_BAR; PG8_SCHED;
        }
        if (wr == 0) PG8_BAR;
        asm volatile("" ::: "memory"); PG8_SCHED;
        { int fr_ = fr, fq_ = fq, tid_ = tid; asm volatile("" : "+v"(fr_), "+v"(fq_), "+v"(tid_));
          E(acc, cur, wr, wc, fr_, fq_, tid_);
          if (EPIP && Epi::twice) { asm volatile("" : "+v"(fr_), "+v"(fq_), "+v"(tid_)); E(acc, cur, wr, wc, fr_, fq_, tid_); } }
        asm volatile("" ::: "memory"); PG8_SCHED;
        if (!has_next) break;
        if (!Epi::keep(cur.mode)) {
#pragma unroll
            for (int a = 0; a < 2; ++a)
#pragma unroll
                for (int b = 0; b < 2; ++b)
#pragma unroll
                    for (int m = 0; m < 4; ++m)
#pragma unroll
                        for (int n = 0; n < 2; ++n) acc[a][b][m][n] = (f32x4){0.f, 0.f, 0.f, 0.f};
        }
        cur = nxt;
        ++ui;
        if (wr == 1) PG8_BAR;
    }
    PG8_WAIT_V(0);
    PG8_BAR;
#undef PG8_SA
#undef PG8_SB
#undef PG8_STAGE
#undef PG8_LDA
#undef PG8_LDB
#undef PG8_MMA
#undef PG8_WAIT_V
#undef PG8_WAIT_L
#undef PG8_BAR
#undef PG8_SCHED
}

typedef f32x4 Acc[2][2][4][2];
__device__ __forceinline__ float quad_sum(float v) {
    const unsigned a = __float_as_uint(v);
    auto r = __builtin_amdgcn_permlane16_swap(a, a, false, false);
    const float t = __uint_as_float(r[0]) + __uint_as_float(r[1]);
    const unsigned b = __float_as_uint(t);
    auto q = __builtin_amdgcn_permlane32_swap(b, b, false, false);
    return __uint_as_float(q[0]) + __uint_as_float(q[1]);
}
template <bool MSQ>
__device__ __forceinline__ void row_rstd_(float (&rs)[2][4], float (&msq)[2][4], const float* ssp, int row0, int fq) {
#pragma unroll
    for (int ai = 0; ai < 2; ++ai)
#pragma unroll
        for (int m = 0; m < 4; ++m) {
            const f32x4 p = *(const f32x4*)(ssp + (size_t)(row0 + ai * HALF + m * 16) * 16 + 4 * fq);
            float s = (p[0] + p[1]) + (p[2] + p[3]);
            s = quad_sum(s);
            const float q = (s + EPS * DM) * (1.0f / DM);
            rs[ai][m] = __builtin_amdgcn_rsqf(q);
            if (MSQ) msq[ai][m] = q;
        }
}
__device__ __forceinline__ void row_rstd(float (&rs)[2][4], const float* ssp, int row0, int fq) {
#pragma unroll
    for (int ai = 0; ai < 2; ++ai)
#pragma unroll
        for (int m = 0; m < 4; ++m) {
            const f32x4 p = *(const f32x4*)(ssp + (size_t)(row0 + ai * HALF + m * 16) * 16 + 4 * fq);
            float s = (p[0] + p[1]) + (p[2] + p[3]);
            s = quad_sum(s);
            rs[ai][m] = __builtin_amdgcn_rsqf((s + EPS * DM) * (1.0f / DM));
        }
}
constexpr int RQ_OFF = 131072;
template <class Sched>
__device__ __forceinline__ void rowq_table(LAS unsigned char* lds, const unsigned char* ws, const Sched& S) {
    const int tid = otid();
    const float* ssp = (const float*)(ws + WS_SSP);
    LAS float* tab = (LAS float*)(lds + RQ_OFF);
    for (int e = tid; ; e += 512) {
        GUnit u; if (!S.get(e >> 8, u)) break;
        const float* p = ssp + (size_t)(u.pm * BM + (e & 255)) * 16;
        const f32x4 a = *(const f32x4*)p, b = *(const f32x4*)(p + 4), c = *(const f32x4*)(p + 8), d = *(const f32x4*)(p + 12);
        const float sm = (((a[0] + a[1]) + (a[2] + a[3])) + ((b[0] + b[1]) + (b[2] + b[3]))) + (((c[0] + c[1]) + (c[2] + c[3])) + ((d[0] + d[1]) + (d[2] + d[3])));
        tab[e] = (sm + EPS * DM) * (1.0f / DM);
    }
    __syncthreads();
}
template <bool MSQ>
__device__ __forceinline__ void row_rstd_lds(float (&rs)[2][4], float (&msq)[2][4], int ui, int wr, int fr) {
    extern __shared__ __attribute__((aligned(16))) unsigned char lds_raw[];
    const LAS float* t = (const LAS float*)((LAS unsigned char*)lds_raw + RQ_OFF) + ui * 256 + wr * 64 + fr;
#pragma unroll
    for (int ai = 0; ai < 2; ++ai)
#pragma unroll
        for (int m = 0; m < 4; ++m) { const float q = t[ai * HALF + m * 16]; rs[ai][m] = __builtin_amdgcn_rsqf(q); if (MSQ) msq[ai][m] = q; }
}
__device__ __forceinline__ float sigmoidf_(float x) { return __builtin_amdgcn_rcpf(1.0f + __builtin_amdgcn_exp2f(-x * LOG2E)); }

struct EpiUp {
    static constexpr bool twice = true;
    unsigned char* ws;
    static __device__ __forceinline__ bool keep(int) { return false; }
    __device__ __forceinline__ void operator()(Acc& acc, const GUnit& u, int wr, int wc, int fr, int fq, int tid) const {
        bf16* H = (bf16*)(ws + WS_ACT); const float* ssp = (const float*)(ws + WS_SSP);
        const int row0 = u.pm * BM + wr * 64 + fr;
        float rs[2][4], msq[2][4]; row_rstd_lds<true>(rs, msq, u.ui, wr, fr);
        const int col0 = u.pn * HALF + wc * 32 + 8 * fq;
#pragma unroll
        for (int ai = 0; ai < 2; ++ai)
#pragma unroll
            for (int m = 0; m < 4; ++m) {
                const float rneg = -rs[ai][m] * LOG2E, q = msq[ai][m]; float h[8];
#pragma unroll
                for (int n = 0; n < 2; ++n)
#pragma unroll
                    for (int e = 0; e < 4; ++e) { const float g = acc[ai][0][m][n][e], up = acc[ai][1][m][n][e];
                        const float ex = __builtin_amdgcn_exp2f(g * rneg); h[4 * n + e] = (g * up) * __builtin_amdgcn_rcpf(__builtin_fmaf(ex, q, q)); }
                u32x4 w; w.x = cvtpk(h[0], h[1]); w.y = cvtpk(h[2], h[3]); w.z = cvtpk(h[4], h[5]); w.w = cvtpk(h[6], h[7]);
                *(u32x4*)(H + (size_t)(row0 + ai * HALF + m * 16) * DFF + col0) = w;
                asm volatile("" ::: "memory");
            }
    }
};
struct EpiRes {
    static constexpr bool twice = false;
    unsigned char* ws; float* outf; float alpha;
    static __device__ __forceinline__ bool keep(int) { return false; }
    __device__ __forceinline__ void operator()(Acc& acc, const GUnit& u, int wr, int wc, int fr, int fq, int tid) const {
        bf16* xb = (bf16*)(ws + WS_XB); float* ssp = (float*)(ws + WS_SSP);
        const int row0 = u.pm * BM + wr * 64 + fr, col0 = u.pn * BM + wc * 32 + 8 * fq;
#pragma unroll
        for (int ai = 0; ai < 2; ++ai) {
        u32x4 bv[4][2];
#pragma unroll
            for (int m = 0; m < 4; ++m)
#pragma unroll
                for (int bj = 0; bj < 2; ++bj) bv[m][bj] = *(const u32x4*)(xb + (size_t)(row0 + ai * HALF + m * 16) * DM + col0 + bj * HALF);
#pragma unroll
            for (int m = 0; m < 4; ++m) {
                const int row = row0 + ai * HALF + m * 16; float ssq = 0.f;
#pragma unroll
                for (int bj = 0; bj < 2; ++bj) {
                    const size_t off = (size_t)row * DM + col0 + bj * HALF;
                    const u32x4 b = bv[m][bj];
                    const f32x4 v0 = (f32x4){bflo(b.x), bfhi(b.x), bflo(b.y), bfhi(b.y)} + alpha * acc[ai][bj][m][0];
                    const f32x4 v1 = (f32x4){bflo(b.z), bfhi(b.z), bflo(b.w), bfhi(b.w)} + alpha * acc[ai][bj][m][1];
                    if (outf) { *(f32x4*)(outf + off) = v0; *(f32x4*)(outf + off + 4) = v1; }
                    else {
                        u32x4 w; w.x = cvtpk(v0[0], v0[1]); w.y = cvtpk(v0[2], v0[3]); w.z = cvtpk(v1[0], v1[1]); w.w = cvtpk(v1[2], v1[3]);
                        *(u32x4*)(xb + off) = w;
                        const float r0 = bflo(w.x), r1 = bfhi(w.x), r2 = bflo(w.y), r3 = bfhi(w.y), r4 = bflo(w.z), r5 = bfhi(w.z), r6 = bflo(w.w), r7 = bfhi(w.w);
                        ssq += (r0 * r0 + r1 * r1) + (r2 * r2 + r3 * r3) + (r4 * r4 + r5 * r5) + (r6 * r6 + r7 * r7);
                    }
                }
                if (!outf) {
                    ssq = quad_sum(ssq);
                    if (fq == 0) ssp[(size_t)row * 16 + 4 * u.pn + wc] = ssq;
                }
            }
            asm volatile("" ::: "memory");
        }
    }
};
struct EpiWin {
    static constexpr bool twice = false;
    unsigned char* ws; int l;
    static __device__ __forceinline__ bool keep(int) { return false; }
    __device__ __forceinline__ void operator()(Acc& acc, const GUnit& u, int wr, int wc, int fr, int fq, int tid) const {
        const int slot = 4 * u.pn + wc;
        if (slot >= 54 && u.pn < 14) return;
        bf16* act = (bf16*)(ws + WS_ACT); const float* ssp = (const float*)(ws + WS_SSP); const float* par = (const float*)(ws + WS_PAR) + l * 4096;
        const int row0 = u.pm * BM + wr * 64 + fr;
        float rs[2][4], msq_[2][4]; row_rstd_lds<false>(rs, msq_, u.ui, wr, fr);
        if (u.pn >= 14) {
            const int x = (u.pn - 14) >> 2, col0 = ((u.pn - 14) & 3) * BM + wc * 32 + 8 * fq;
            const float* bgate = par + 512 + x * DM;
            LOCAL_F(k255, 1.0f / 255.0f);
            unsigned char* gdst = ws + WS_GATES + (size_t)((x * (M / BM) + u.pm) * 4 + ((u.pn - 14) & 3)) * 65536 + (wr * 4 + wc) * 8192 + (fq * 16 + fr) * 8 + 4096;
#pragma unroll
            for (int bj = 0; bj < 2; ++bj) {
                const f32x4 bv0 = *(const f32x4*)(bgate + col0 + bj * HALF) * (-LOG2E), bv1 = *(const f32x4*)(bgate + col0 + bj * HALF + 4) * (-LOG2E);
#pragma unroll
                for (int ai = 0; ai < 2; ++ai)
#pragma unroll
                    for (int m = 0; m < 4; ++m) {
                        u32x2 w; w.x = 0u; w.y = 0u;
                        const float rneg = -rs[ai][m] * LOG2E;
#pragma unroll
                        for (int j = 0; j < 4; ++j) {
                            w.x = __builtin_amdgcn_cvt_pk_u8_f32(__builtin_amdgcn_rcpf(__builtin_fmaf(__builtin_amdgcn_exp2f(__builtin_fmaf(acc[ai][bj][m][0][j], rneg, bv0[j])), k255, k255)), j, w.x);
                            w.y = __builtin_amdgcn_cvt_pk_u8_f32(__builtin_amdgcn_rcpf(__builtin_fmaf(__builtin_amdgcn_exp2f(__builtin_fmaf(acc[ai][bj][m][1][j], rneg, bv1[j])), k255, k255)), j, w.y); }
                        *(u32x2*)(gdst + (((ai * 4 + m) * 2 + bj) * 512 - 4096)) = w;
                    }
            }
            return;
        }
        const bool rope = (slot >= SL_CQ && slot < SL_FK) || (slot >= SL_CK && slot < SL_FV) || (slot >= SL_IQ && slot <= SL_IK);
        if (slot == SL_MISC) {
            float* logf = (float*)(ws + WS_LOGF); float* wi = (float*)(ws + WS_WI);
#pragma unroll
            for (int ai = 0; ai < 2; ++ai)
#pragma unroll
                for (int m = 0; m < 4; ++m) {
                    const int row = row0 + ai * HALF + m * 16; const float r = rs[ai][m];
                    if (fq == 0) {
                        const int b = row >> 12, s = row & (SEQ - 1);
#pragma unroll
                        for (int j = 0; j < 6; ++j) { const float z = acc[ai][0][m][j >> 2][j & 3] * r + par[384 + j];
                            const float lf = fminf(z, 0.f) - 0.6931471805599453f * __builtin_amdgcn_logf(1.0f + __builtin_amdgcn_exp2f(-fabsf(z) * LOG2E));
                            logf[((size_t)b * 6 + j) * SEQ + s] = lf; }
                    } else if (fq == 1) {
                        f32x4 w = acc[ai][0][m][0] * (r * 0.5f * 0.125f);
                        *(f32x4*)(wi + (size_t)row * 4) = w;
                    }
                }
            return;
        }
        const bool norm = slot < SL_FV;
        const int gidx = slot < SL_SQ ? 0 : slot < SL_CQ ? 2 : slot < SL_FK ? 4 : slot < SL_SK ? 1 : slot < SL_CK ? 3 : 5;
        const float* gp = par + 64 * gidx;
        LOCAL_F(kC2, C2);
        const float qs = slot < SL_FK ? kC2 : 1.0f;
        int lb0 = 8 * fq, lb1 = 32 + 8 * fq;
        if (rope) { if (fq == 1) lb0 = 32; if (fq == 0) lb1 = 8; }
        f32x4 g[2][2];
        g[0][0] = *(const f32x4*)(gp + lb0); g[0][1] = *(const f32x4*)(gp + lb0 + 4); g[1][0] = *(const f32x4*)(gp + lb1); g[1][1] = *(const f32x4*)(gp + lb1 + 4);
        const int* pos = (const int*)(ws + WS_POS);
        int posv[2][4];
#pragma unroll
        for (int ai = 0; ai < 2; ++ai)
#pragma unroll
            for (int m = 0; m < 4; ++m) posv[ai][m] = pos[row0 + ai * HALF + m * 16];
        bf16* dst; int dstride;
        if (slot < SL_FK) { dst = act + (size_t)slot * 64 + 8 * fq; dstride = ACTP; }
        else if (slot < SL_IQ) { dst = (bf16*)(ws + WS_KVH) + (size_t)(slot - 16) * M * 64 + 8 * fq; dstride = 64; }
        else if (slot < SL_IK) { dst = act + (size_t)(A_IQ + slot - SL_IQ) * 64 + 8 * fq; dstride = ACTP; }
        else { dst = (bf16*)(ws + WS_KVH) + (size_t)KV_IK * M * 64 + 8 * fq; dstride = 64; }
#pragma unroll
        for (int ai = 0; ai < 2; ++ai)
#pragma unroll
            for (int m = 0; m < 4; ++m) {
                const int row = row0 + ai * HALF + m * 16; const float r = rs[ai][m];
                f32x4 z[2][2];
#pragma unroll
                for (int bj = 0; bj < 2; ++bj)
#pragma unroll
                    for (int n = 0; n < 2; ++n) z[bj][n] = acc[ai][bj][m][n] * r;
                if (norm) {
                    float ss = 0.f;
#pragma unroll
                    for (int bj = 0; bj < 2; ++bj)
#pragma unroll
                        for (int n = 0; n < 2; ++n) ss += (z[bj][n][0] * z[bj][n][0] + z[bj][n][1] * z[bj][n][1]) + (z[bj][n][2] * z[bj][n][2] + z[bj][n][3] * z[bj][n][3]);
                    ss = quad_sum(ss);
                    const float hn = qs * __builtin_amdgcn_rsqf((ss + EPS * 64.0f) * (1.0f / 64.0f));
#pragma unroll
                    for (int bj = 0; bj < 2; ++bj)
#pragma unroll
                        for (int n = 0; n < 2; ++n) z[bj][n] = z[bj][n] * (g[bj][n] * hn);
                }
                if (rope && fq == 0) {
                    const float pf = (float)posv[ai][m];
                    const float invf[8] = {1.0f, 0.19393070f, 0.037609117f, 0.0072935625f, 0.0014144452f, 0.00027430436f, 5.3196042e-05f, 1.0316346e-05f};
#pragma unroll
                    for (int j = 0; j < 8; ++j) {
                        const float ang = pf * invf[j]; float rev = ang * 0.15915494309189535f; rev = rev - floorf(rev);
                        const float sn = __builtin_amdgcn_sinf(rev), cs = __builtin_amdgcn_cosf(rev);
                        const float x1 = z[0][j >> 2][j & 3], x2 = z[1][j >> 2][j & 3];
                        z[0][j >> 2][j & 3] = x1 * cs - x2 * sn; z[1][j >> 2][j & 3] = x2 * cs + x1 * sn;
                    }
                }
#pragma unroll
                for (int bj = 0; bj < 2; ++bj) {
                    u32x4 w; w.x = cvtpk(z[bj][0][0], z[bj][0][1]); w.y = cvtpk(z[bj][0][2], z[bj][0][3]); w.z = cvtpk(z[bj][1][0], z[bj][1][1]); w.w = cvtpk(z[bj][1][2], z[bj][1][3]);
                    *(u32x4*)(dst + (size_t)row * dstride + 32 * bj) = w;
                }
                asm volatile("" ::: "memory");
            }
    }
};
struct EpiMerge {
    static constexpr bool twice = false;
    unsigned char* ws;
    static __device__ __forceinline__ bool keep(int mode) { return mode < 2; }
    __device__ __forceinline__ void operator()(Acc& acc, const GUnit& u, int wr, int wc, int fr, int fq, int tid) const {
        const int x = u.mode;
        LOCAL_F(k255, 1.0f / 255.0f);
        const int row0 = u.pm * BM + wr * 64 + fr, col0 = u.pn * BM + wc * 32 + 8 * fq;
        const size_t goff = (size_t)(u.pm * 4 + u.pn) * 65536 + (wr * 4 + wc) * 8192 + (fq * 16 + fr) * 8 + 4096;
        const unsigned char* ga_p = ws + WS_GATES + (size_t)x * (M / BM) * 4 * 65536 + goff;
        const unsigned char* gb_p = ws + WS_GATES + (size_t)(x < 2 ? x + 1 : x) * (M / BM) * 4 * 65536 + goff;
        bf16* merged = (bf16*)(ws + WS_ACT) + SL_MERGED * 64;
        u32x2 gav[2][4][2], gbv[2][4][2];
#pragma unroll
        for (int ai = 0; ai < 2; ++ai)
#pragma unroll
            for (int m = 0; m < 4; ++m)
#pragma unroll
                for (int bj = 0; bj < 2; ++bj) { const int go = ((ai * 4 + m) * 2 + bj) * 512 - 4096; gav[ai][m][bj] = *(const u32x2*)(ga_p + go); gbv[ai][m][bj] = *(const u32x2*)(gb_p + go); }
#pragma unroll
        for (int ai = 0; ai < 2; ++ai)
#pragma unroll
            for (int m = 0; m < 4; ++m) {
                const size_t ro = (size_t)(row0 + ai * HALF + m * 16);
#pragma unroll
                for (int bj = 0; bj < 2; ++bj) {
                    const u32x2 ga = gav[ai][m][bj], gb = gbv[ai][m][bj];
                    float o[8];
#pragma unroll
                    for (int j = 0; j < 8; ++j) {
                        const float fa = (float)(((j < 4 ? ga.x : ga.y) >> (8 * (j & 3))) & 255u), fb = (float)(((j < 4 ? gb.x : gb.y) >> (8 * (j & 3))) & 255u);
                        const float fa2 = x == 0 ? fa : fmaxf(fa, 0.5f);
                        const float f = (x < 2) ? fa2 * __builtin_amdgcn_rcpf(fmaxf(fb, 0.5f)) : fa2 * k255;
                        o[j] = acc[ai][bj][m][j >> 2][j & 3] * f; acc[ai][bj][m][j >> 2][j & 3] = o[j];
                    }
                    if (x == 2) { u32x4 w; w.x = cvtpk(o[0], o[1]); w.y = cvtpk(o[2], o[3]); w.z = cvtpk(o[4], o[5]); w.w = cvtpk(o[6], o[7]);
                        *(u32x4*)(merged + ro * ACTP + col0 + bj * HALF) = w; }
                }
            }
    }
};
}

namespace att {
constexpr int NW = 8, QBLK = 32, QB = 256, KVBLK = 64, SLOTB = 8192;
constexpr int LDS_K = 0, LDS_V = 2 * SLOTB, LDS_WS = 4 * SLOTB, LDS_OST = LDS_WS + NW * 256, LDS_F = LDS_OST + NW * 4096, LDS_END = LDS_F + 4096 * 4 + 64 + 64;
static_assert(LDS_END <= RING_BYTES, "attention LDS");
typedef const LAS char* lptr;
__device__ __forceinline__ int crow(int r, int hi) { return (r & 3) + 8 * (r >> 2) + 4 * hi; }
__device__ __forceinline__ void glds16(const void* gsrc, unsigned lds_dst) { unsigned keep;
    asm volatile("s_mov_b32 %0, m0\n\ts_mov_b32 m0, %2\n\ts_nop 0\n\tglobal_load_lds_dwordx4 %1, off\n\ts_mov_b32 m0, %0" : "=&s"(keep) : "v"(gsrc), "s"(lds_dst) : "memory"); }
#define ATT_WAIT_BAR() asm volatile("s_waitcnt vmcnt(0) lgkmcnt(0)\n\ts_barrier" ::: "memory")
#define MFMA32(a, b, c) __builtin_amdgcn_mfma_f32_32x32x16_bf16(a, b, c, 0, 0, 0)
__device__ __forceinline__ void qkt(f32x16& p0, f32x16& p1, lptr kslot, const bf16x8* qr, int r32, int hi) {
    lptr kb = kslot + hi * 1024 + r32 * 16;
    f32x16 z = {};
    p0 = z; p1 = z;
#pragma unroll
    for (int d0 = 0; d0 < 4; ++d0) {
        const bf16x8 b0 = *(const LAS bf16x8*)(kb + d0 * 2048);
        const bf16x8 b1 = *(const LAS bf16x8*)(kb + d0 * 2048 + 512);
        p0 = MFMA32(b0, qr[d0], p0); p1 = MFMA32(b1, qr[d0], p1);
    }
}
__device__ __forceinline__ s16x4 vtr(lptr p) { return __builtin_bit_cast(s16x4, __builtin_amdgcn_ds_read_tr16_b64_v4i16((LAS v4i16_t*)p)); }
__device__ __forceinline__ void pv(f32x16* o, lptr vp, const f32x16& p0, const f32x16& p1) {
    u32x4 pw[4];
    pw[0] = (u32x4){cvtpk(p0[0], p0[1]), cvtpk(p0[2], p0[3]), cvtpk(p0[4], p0[5]), cvtpk(p0[6], p0[7])};
    pw[1] = (u32x4){cvtpk(p0[8], p0[9]), cvtpk(p0[10], p0[11]), cvtpk(p0[12], p0[13]), cvtpk(p0[14], p0[15])};
    pw[2] = (u32x4){cvtpk(p1[0], p1[1]), cvtpk(p1[2], p1[3]), cvtpk(p1[4], p1[5]), cvtpk(p1[6], p1[7])};
    pw[3] = (u32x4){cvtpk(p1[8], p1[9]), cvtpk(p1[10], p1[11]), cvtpk(p1[12], p1[13]), cvtpk(p1[14], p1[15])};
#pragma unroll
    for (int d0 = 0; d0 < 2; ++d0)
#pragma unroll
        for (int ks = 0; ks < 4; ++ks) {
            const s16x4 lo = vtr(vp + d0 * 4096 + ks * 1024), hi = vtr(vp + d0 * 4096 + ks * 1024 + 512);
            const bf16x8 vf = (bf16x8){lo[0], lo[1], lo[2], lo[3], hi[0], hi[1], hi[2], hi[3]};
            o[d0] = MFMA32(__builtin_bit_cast(bf16x8, pw[ks]), vf, o[d0]);
        }
}
__device__ __forceinline__ float rowmax(const f32x16& p0, const f32x16& p1) {
    float a = fmaxf(p0[0], p1[0]);
#pragma unroll
    for (int r = 1; r < 16; ++r) a = fmaxf(a, fmaxf(p0[r], p1[r]));
    auto rr = __builtin_amdgcn_permlane32_swap(__float_as_uint(a), __float_as_uint(a), false, false);
    return fmaxf(__uint_as_float(rr[0]), __uint_as_float(rr[1]));
}
__device__ __forceinline__ float partner(float v) {
    const unsigned me = __float_as_uint(v);
    auto rr = __builtin_amdgcn_permlane32_swap(me, me, false, false);
    return __uint_as_float(rr[0] == me ? rr[1] : rr[0]);
}

enum { A_FOX = 0, A_SB = 1, A_DSA = 2 };
template <int MODE>
__device__ __forceinline__ void attn_unit(int b, int sq, int sk, int sv, int so, int qb, bf16* ACT, const bf16* KVH, const float* logf_bh, const unsigned* maskw, float smax, LAS char* shm, gu32* qctr, volatile LAS unsigned* nslot) {
    int tid = otid();
    const int lane = tid & 63, r32 = lane & 31, hi = lane >> 5; const int wid = __builtin_amdgcn_readfirstlane(tid >> 6);
    const long rowbase = (long)b * SEQ; const int q0 = qb * QB;
    const bf16* Qw = ACT + (rowbase + q0 + wid * QBLK) * ACTP + sq * 64;
    const bf16* Kh = KVH + ((size_t)sk * M + rowbase) * 64; const bf16* Vh = KVH + ((size_t)sv * M + rowbase) * 64;
    const unsigned lds0 = (unsigned)(uintptr_t)shm;
    LAS float* wsf = (LAS float*)(shm + LDS_WS) + wid * 64;
    LAS float* F2 = (LAS float*)(shm + LDS_F);
    LAS unsigned* sbflag = (LAS unsigned*)(shm + LDS_F);
    LAS unsigned* exflag = (LAS unsigned*)(shm + LDS_F + 4096 * 4 + 64);
    const bf16* ksrc = Kh + (long)lane * 64 + wid * 8;
    const bf16* vsrc = Vh + (long)(16 * (wid & 3) + (lane >> 2)) * 64 + (wid >> 2) * 32 + (lane & 3) * 8;
    const unsigned kdst = lds0 + LDS_K + wid * 1024, vdst = lds0 + LDS_V + wid * 1024;
#define DMA_K(t, slot) glds16(ksrc + (long)(t) * KVBLK * 64, (unsigned)__builtin_amdgcn_readfirstlane(kdst + (slot)))
#define DMA_V(t, slot) glds16(vsrc + (long)(t) * KVBLK * 64, (unsigned)__builtin_amdgcn_readfirstlane(vdst + (slot)))
    lptr kbase = (lptr)shm + LDS_K;
    lptr vp0 = (lptr)shm + LDS_V + ((lane >> 4) & 1) * 32 + (lane & 3) * 8 + (4 * hi + ((lane & 15) >> 2)) * 64;
    const int NT = (q0 + QB) / KVBLK;
#define TILE_AT(i) ((MODE != A_DSA) ? NT - 1 - (i) : (i))
    DMA_K(TILE_AT(0), 0); DMA_V(TILE_AT(0), 0); DMA_K(TILE_AT(1), SLOTB);
    bf16x8 qr[4];
#pragma unroll
    for (int d0 = 0; d0 < 4; ++d0) qr[d0] = *reinterpret_cast<const bf16x8*>(&Qw[(long)r32 * ACTP + d0 * 16 + hi * 8]);
    const int qrel = wid * QBLK + r32, qabs = q0 + qrel;
    float Fq = 0.f;
    if (MODE == A_FOX) {
        const int n = q0 + QB;
        float v[8]; float run = 0.f;
        if (8 * tid < n) { const f32x4 a = *(const f32x4*)(logf_bh + 8 * tid), c = *(const f32x4*)(logf_bh + 8 * tid + 4);
            v[0] = a[0]; v[1] = a[1]; v[2] = a[2]; v[3] = a[3]; v[4] = c[0]; v[5] = c[1]; v[6] = c[2]; v[7] = c[3]; }
        else {
#pragma unroll
            for (int j = 0; j < 8; ++j) v[j] = 0.f; }
#pragma unroll
        for (int j = 0; j < 8; ++j) { run += v[j]; v[j] = run; }
        float inc = run;
#pragma unroll
        for (int o = 1; o < 64; o <<= 1) { const float t = __int_as_float(__builtin_amdgcn_ds_bpermute(((lane >= o ? lane - o : lane)) << 2, __float_as_int(inc))); if (lane >= o) inc += t; }
        LAS float* wtot = (LAS float*)(shm + LDS_F + 4096 * 4);
        if (lane == 63) wtot[wid] = inc;
        __syncthreads();
        float base = inc - run;
        for (int w = 0; w < wid; ++w) base += wtot[w];
        if (8 * tid < n) {
            *(LAS f32x4*)(F2 + 8 * tid) = (f32x4){(base + v[0]) * LOG2E, (base + v[1]) * LOG2E, (base + v[2]) * LOG2E, (base + v[3]) * LOG2E};
            *(LAS f32x4*)(F2 + 8 * tid + 4) = (f32x4){(base + v[4]) * LOG2E, (base + v[5]) * LOG2E, (base + v[6]) * LOG2E, (base + v[7]) * LOG2E};
        }
        __syncthreads();
        Fq = F2[qabs];
    }
    LOCAL_F(NEGINF, -INFINITY);
    float mrun = NEGINF, lsum = 0.f, cq = 1.0f;
    f32x16 o[2]; o[0] = f32x16{}; o[1] = f32x16{};
    f32x16 pA0, pA1, pB0, pB1;
    unsigned mwA = 0u, mwB = 0u;
    ATT_WAIT_BAR();
    qkt(pA0, pA1, kbase, qr, r32, hi);
    if (MODE == A_DSA) mwA = maskw[((size_t)TILE_AT(0) * SEQ + qabs) * 2 + hi];
    ATT_WAIT_BAR();
    bool stop = false;
#define ATT_STEP(C0, C1, N0, N1, MWC, MWN, IT) do { \
        const int it = (IT); const int t = TILE_AT(it); \
        const int slot = (it & 1) * SLOTB; \
        if (it + 2 < NT) DMA_K(TILE_AT(it + 2), slot); \
        if (it + 1 < NT) { DMA_V(TILE_AT(it + 1), SLOTB - slot); \
            qkt(N0, N1, kbase + (SLOTB - slot), qr, r32, hi); \
            if (MODE == A_DSA) MWN = maskw[((size_t)TILE_AT(it + 1) * SEQ + qabs) * 2 + hi]; } \
        const int kv0 = t * KVBLK; \
        const bool band = (t >= NT - 4); \
        if (MODE == A_FOX || MODE == A_DSA) { \
            if (MODE == A_FOX) { \
                _Pragma("unroll") for (int g = 0; g < 4; ++g) { \
                    const f32x4 f0 = *(const LAS f32x4*)(F2 + kv0 + 8 * g + 4 * hi), f1 = *(const LAS f32x4*)(F2 + kv0 + 32 + 8 * g + 4 * hi); \
                    _Pragma("unroll") for (int e = 0; e < 4; ++e) { C0[4 * g + e] += Fq - f0[e]; C1[4 * g + e] += Fq - f1[e]; } \
                } \
            } \
            if (MODE == A_DSA) { \
                _Pragma("unroll") for (int r = 0; r < 16; ++r) { if (!__builtin_amdgcn_ubfe(MWC, r, 1)) C0[r] = NEGINF; if (!__builtin_amdgcn_ubfe(MWC, 16 + r, 1)) C1[r] = NEGINF; } \
            } \
            if (band) { \
                _Pragma("unroll") for (int r = 0; r < 16; ++r) { const int kv = kv0 + crow(r, hi); if (kv > qabs) C0[r] = NEGINF; if (kv + 32 > qabs) C1[r] = NEGINF; } \
            } \
            const float rm = rowmax(C0, C1); \
            const float mnew = fmaxf(mrun, rm); \
            const float msafe = (mnew == NEGINF) ? 0.f : mnew; \
            const float alpha = __builtin_amdgcn_exp2f(mrun - msafe); \
            float ssum = 0.f; \
            _Pragma("unroll") for (int r = 0; r < 16; ++r) { C0[r] = __builtin_amdgcn_exp2f(C0[r] - msafe); C1[r] = __builtin_amdgcn_exp2f(C1[r] - msafe); ssum += C0[r] + C1[r]; } \
            lsum = lsum * alpha + ssum; \
            mrun = mnew; \
            if (__any(alpha != 1.0f)) { \
                if (hi == 0) wsf[r32] = alpha; \
                _Pragma("unroll") for (int r = 0; r < 16; ++r) { const float f = wsf[crow(r, hi)]; o[0][r] *= f; o[1][r] *= f; } \
            } \
        } else {     \
            float rr0[16], rr1[16]; \
            _Pragma("unroll") for (int r = 0; r < 16; ++r) { \
                const float e0 = __builtin_amdgcn_exp2f(fminf(C0[r], 120.f)), e1 = __builtin_amdgcn_exp2f(fminf(C1[r], 120.f)); \
                float q0_ = __builtin_amdgcn_rcpf(1.0f + e0), q1_ = __builtin_amdgcn_rcpf(1.0f + e1); \
                float s0 = e0 * q0_, s1 = e1 * q1_; \
                if (band) { const int kv = kv0 + crow(r, hi); if (kv >= qabs) { q0_ = 1.f; s0 = 0.f; } if (kv + 32 >= qabs) { q1_ = 1.f; s1 = 0.f; } } \
                rr0[r] = q0_; rr1[r] = q1_; C0[r] = s0; C1[r] = s1; \
            } \
              \
            float G[8], Gp[8], T[8]; \
            _Pragma("unroll") for (int g = 0; g < 4; ++g) { G[g] = (rr0[4 * g] * rr0[4 * g + 1]) * (rr0[4 * g + 2] * rr0[4 * g + 3]); G[4 + g] = (rr1[4 * g] * rr1[4 * g + 1]) * (rr1[4 * g + 2] * rr1[4 * g + 3]); } \
            _Pragma("unroll") for (int g = 0; g < 8; ++g) { Gp[g] = partner(G[g]); T[g] = G[g] * Gp[g]; } \
            float suf = cq;          \
            _Pragma("unroll") for (int g = 7; g >= 0; --g) { \
                float bs = suf; if (hi == 0) bs *= Gp[g];       \
                if (g >= 4) { \
                    const int r = 4 * (g - 4); \
                    const float a3 = bs, a2 = a3 * rr1[r + 3], a1 = a2 * rr1[r + 2], a0 = a1 * rr1[r + 1]; \
                    C1[r + 3] *= a3; C1[r + 2] *= a2; C1[r + 1] *= a1; C1[r] *= a0; \
                } else { \
                    const int r = 4 * g; \
                    const float a3 = bs, a2 = a3 * rr0[r + 3], a1 = a2 * rr0[r + 2], a0 = a1 * rr0[r + 1]; \
                    C0[r + 3] *= a3; C0[r + 2] *= a2; C0[r + 1] *= a1; C0[r] *= a0; \
                } \
                suf *= T[g]; \
            } \
            cq = suf; \
        } \
        pv(o, vp0 + slot, C0, C1); \
        if (MODE == A_SB) { if (lane == 0) sbflag[(it & 1) * 8 + wid] = __all(cq == 0.f) ? 1u : 0u; } \
        if (MODE == A_FOX) {       \
            const float fk = t > 0 ? F2[kv0 - 1] : 0.f; \
            const bool dead = t > 0 && (smax + Fq - fk < mrun - 152.0f); \
            if (lane == 0) exflag[(it & 1) * 8 + wid] = __all(dead) ? 1u : 0u; \
        } \
        ATT_WAIT_BAR(); \
        if (MODE == A_FOX) { \
            unsigned alld = 1u; \
            _Pragma("unroll") for (int w = 0; w < 8; ++w) alld &= exflag[(it & 1) * 8 + w]; \
            if (alld) stop = true; \
        } \
        if (MODE == A_SB) {        \
            unsigned alld = 1u; \
            _Pragma("unroll") for (int w = 0; w < 8; ++w) alld &= sbflag[(it & 1) * 8 + w]; \
            if (alld) stop = true; \
        } \
    } while (0)
    for (int it2 = 0; it2 < NT; it2 += 2) {
        ALIGN_LOOP();
        ATT_STEP(pA0, pA1, pB0, pB1, mwA, mwB, it2);
        if (stop) break;
        ATT_STEP(pB0, pB1, pA0, pA1, mwB, mwA, it2 + 1);
        if (stop) break;
    }
#undef ATT_STEP
#undef TILE_AT
    unsigned nx_ = 0u; const bool pop_ = (tid == 0);
    if (pop_) nx_ = __hip_atomic_fetch_add(qctr, 1u, RLX_AGENT);
    float rli[16];
    if (MODE == A_SB) {
#pragma unroll
        for (int r = 0; r < 16; ++r) rli[r] = 1.0f;
    } else {
        const float lt = lsum + partner(lsum);
        if (hi == 0) wsf[32 + r32] = lt;
#pragma unroll
        for (int r = 0; r < 16; ++r) rli[r] = 1.0f / wsf[32 + crow(r, hi)];
    }
    bf16* Ow = ACT + (rowbase + q0 + wid * QBLK) * ACTP + so * 64;
    {
        LAS bf16* stg = (LAS bf16*)(shm + LDS_OST) + wid * 2048;
#pragma unroll
        for (int r = 0; r < 16; ++r) { const int orow = crow(r, hi);
#pragma unroll
            for (int d0 = 0; d0 < 2; ++d0) stg[orow * 64 + d0 * 32 + r32] = (bf16)(cvtpk(o[d0][r] * rli[r], 0.f) & 0xffffu); }
        asm volatile("s_waitcnt lgkmcnt(0)" ::: "memory");
#pragma unroll
        for (int i = 0; i < 4; ++i) { const int row = i * 8 + (lane >> 3), ch = lane & 7; const u32x4 v = *(const LAS u32x4*)(stg + row * 64 + ch * 8); *(u32x4*)(Ow + (long)row * ACTP + ch * 8) = v; }
    }
    if (pop_) *nslot = nx_;
    ATT_WAIT_BAR();
#undef DMA_K
#undef DMA_V
}

constexpr int XL_K = 0, XL_V = 3 * SLOTB, XL_WS = 6 * SLOTB, XL_OST = XL_WS + NW * 256, XL_F = XL_OST + NW * 4096, XL_END = XL_F + 4096 * 4 + 128;
static_assert(XL_END <= RING_BYTES, "attention LDS");
template <int MODE, int THRL>
__device__ __forceinline__ void attn_unit_x(int b, int sq, int sk, int sv, int so, int qb, bf16* ACT, const bf16* KVH, const float* logf_bh, const unsigned* maskw, float smax, LAS char* shm, gu32* qctr, volatile LAS unsigned* nslot) {
    int tid = otid();
    const int lane = tid & 63, r32 = lane & 31, hi = lane >> 5; const int wid = __builtin_amdgcn_readfirstlane(tid >> 6);
    const long rowbase = (long)b * SEQ; const int q0 = qb * QB;
    const bf16* Qw = ACT + (rowbase + q0 + wid * QBLK) * ACTP + sq * 64;
    const bf16* Kh = KVH + ((size_t)sk * M + rowbase) * 64; const bf16* Vh = KVH + ((size_t)sv * M + rowbase) * 64;
    const unsigned lds0 = (unsigned)(uintptr_t)shm;
    LAS float* wsf = (LAS float*)(shm + XL_WS) + wid * 64;
    LAS float* F2 = (LAS float*)(shm + XL_F);
    LAS unsigned* exflag = (LAS unsigned*)(shm + XL_F + 4096 * 4 + 64);
    const bf16* ksrc = Kh + (long)lane * 64 + wid * 8;
    const bf16* vsrc = Vh + (long)(16 * (wid & 3) + (lane >> 2)) * 64 + (wid >> 2) * 32 + (lane & 3) * 8;
    const unsigned kdst = lds0 + XL_K + wid * 1024, vdst = lds0 + XL_V + wid * 1024;
    const int NT = (q0 + QB) / KVBLK;
#define TILE(i) ((MODE == A_FOX) ? NT - 1 - (i) : (i))
#define DMA_K(i, slot) glds16(ksrc + (long)TILE(i) * KVBLK * 64, (unsigned)__builtin_amdgcn_readfirstlane(kdst + (slot)))
#define DMA_V(i, slot) glds16(vsrc + (long)TILE(i) * KVBLK * 64, (unsigned)__builtin_amdgcn_readfirstlane(vdst + (slot)))
#define XWAIT_BAR(N) asm volatile("s_waitcnt vmcnt(" #N ") lgkmcnt(0)\n\ts_barrier" ::: "memory")
#define SBAR() __builtin_amdgcn_sched_barrier(0)
    lptr kp0 = (lptr)shm + XL_K + hi * 1024 + r32 * 16;
    lptr vp0 = (lptr)shm + XL_V + ((lane >> 4) & 1) * 32 + (lane & 3) * 8 + (4 * hi + ((lane & 15) >> 2)) * 64;
    DMA_K(0, 0); DMA_V(0, 0); DMA_K(1, SLOTB);
    bf16x8 qr[4];
#pragma unroll
    for (int d0 = 0; d0 < 4; ++d0) qr[d0] = *reinterpret_cast<const bf16x8*>(&Qw[(long)r32 * ACTP + d0 * 16 + hi * 8]);
    const int qabs = q0 + wid * QBLK + r32;
    float Fq = 0.f;
    if (MODE == A_FOX) {
        const int n = q0 + QB;
        float v[8]; float run = 0.f;
        if (8 * tid < n) { const f32x4 a = *(const f32x4*)(logf_bh + 8 * tid), c = *(const f32x4*)(logf_bh + 8 * tid + 4);
            v[0] = a[0]; v[1] = a[1]; v[2] = a[2]; v[3] = a[3]; v[4] = c[0]; v[5] = c[1]; v[6] = c[2]; v[7] = c[3]; }
        else {
#pragma unroll
            for (int j = 0; j < 8; ++j) v[j] = 0.f; }
#pragma unroll
        for (int j = 0; j < 8; ++j) { run += v[j]; v[j] = run; }
        float inc = run;
#pragma unroll
        for (int o_ = 1; o_ < 64; o_ <<= 1) { const float t_ = __int_as_float(__builtin_amdgcn_ds_bpermute(((lane >= o_ ? lane - o_ : lane)) << 2, __float_as_int(inc))); if (lane >= o_) inc += t_; }
        LAS float* wtot = (LAS float*)(shm + XL_F + 4096 * 4);
        if (lane == 63) wtot[wid] = inc;
        __syncthreads();
        float base = inc - run;
        for (int w = 0; w < wid; ++w) base += wtot[w];
        if (8 * tid < n) {
            *(LAS f32x4*)(F2 + 8 * tid) = (f32x4){(base + v[0]) * LOG2E, (base + v[1]) * LOG2E, (base + v[2]) * LOG2E, (base + v[3]) * LOG2E};
            *(LAS f32x4*)(F2 + 8 * tid + 4) = (f32x4){(base + v[4]) * LOG2E, (base + v[5]) * LOG2E, (base + v[6]) * LOG2E, (base + v[7]) * LOG2E};
        }
        __syncthreads();
        Fq = F2[qabs];
    }
    const unsigned* mwp = maskw + (size_t)qabs * 2 + hi;
    float mhat = 0.f, l_reg = 0.f; f32x16 o[2]; o[0] = f32x16{}; o[1] = f32x16{};
    float msh = 0.f;
    LOCAL_F(NEGINF, -INFINITY);
    f32x16 negm = f32x16{};
#define CINIT negm
    bool resc = false, stop = false, wdead = false;
    const int qlast_w = q0 + wid * QBLK + QBLK - 1;
#define APPLY(P0, P1, i, MW) do { const int T_ = TILE(i), kv0_ = T_ * KVBLK; \
        if (MODE == A_FOX) { _Pragma("unroll") for (int g = 0; g < 4; ++g) { \
            const f32x4 f0 = *(const LAS f32x4*)(F2 + kv0_ + 8 * g + 4 * hi), f1 = *(const LAS f32x4*)(F2 + kv0_ + 32 + 8 * g + 4 * hi); \
            _Pragma("unroll") for (int e = 0; e < 4; ++e) { P0[4 * g + e] -= f0[e]; P1[4 * g + e] -= f1[e]; } \
            SBAR(); } }        \
        if (MODE == A_DSA) { _Pragma("unroll") for (int r = 0; r < 16; ++r) { if (!__builtin_amdgcn_ubfe((MW), r, 1)) P0[r] = NEGINF; if (!__builtin_amdgcn_ubfe((MW), 16 + r, 1)) P1[r] = NEGINF; } } \
        if (T_ >= NT - 4) { _Pragma("unroll") for (int r = 0; r < 16; ++r) { const int kv = kv0_ + crow(r, hi); if (kv > qabs) P0[r] = NEGINF; if (kv + 32 > qabs) P1[r] = NEGINF; } } \
    } while (0)
#define RESC() do { if (resc) { asm volatile("s_waitcnt lgkmcnt(0)" ::: "memory"); \
        _Pragma("unroll") for (int d_ = 0; d_ < 2; ++d_) _Pragma("unroll") for (int r = 0; r < 16; ++r) o[d_][r] *= wsf[crow(r, hi)]; } } while (0)
    f32x16 pA0, pA1, pB0, pB1; bf16x8 kf[8]; s16x4 vlo[8], vhi[8]; u32x4 pw0, pw1, pw2, pw3;
    unsigned mwA = 0u, mwB = 0u;
    int sl_prev = 0, sl_cur = 0, sl_next = SLOTB;
#define ROT() do { sl_prev = sl_cur; sl_cur = sl_next; sl_next = (sl_next == 2 * SLOTB) ? 0 : sl_next + SLOTB; } while (0)
#define KLOAD2(j, kp) do { kf[2 * (j)] = *(const LAS bf16x8*)((kp) + (j) * 2048); kf[2 * (j) + 1] = *(const LAS bf16x8*)((kp) + (j) * 2048 + 512); } while (0)
    if (MODE == A_DSA) { mwA = mwp[(size_t)TILE(0) * SEQ * 2]; mwB = mwp[(size_t)TILE(1) * SEQ * 2]; }
    DMA_K(2, 2 * SLOTB);
    XWAIT_BAR(3);
    KLOAD2(0, kp0); KLOAD2(1, kp0); KLOAD2(2, kp0); KLOAD2(3, kp0);
    pA0 = MFMA32(kf[0], qr[0], CINIT); pA1 = MFMA32(kf[1], qr[0], CINIT); pA0 = MFMA32(kf[2], qr[1], pA0); pA1 = MFMA32(kf[3], qr[1], pA1);
    pA0 = MFMA32(kf[4], qr[2], pA0); pA1 = MFMA32(kf[5], qr[2], pA1); pA0 = MFMA32(kf[6], qr[3], pA0); pA1 = MFMA32(kf[7], qr[3], pA1);
    APPLY(pA0, pA1, 0, mwA);
    if (MODE == A_DSA) mwA = mwp[(size_t)TILE(2) * SEQ * 2];
    { const float rm = rowmax(pA0, pA1); const float dl = (rm > -3.0e38f) ? rm : 0.f; mhat += dl; msh = dl;
#pragma unroll
      for (int r = 0; r < 16; ++r) { pA0[r] = __builtin_amdgcn_exp2f(pA0[r] - dl); pA1[r] = __builtin_amdgcn_exp2f(pA1[r] - dl); negm[r] = -dl; } }
    XWAIT_BAR(0);
    DMA_K(3, 0); DMA_V(1, SLOTB);
    ROT();
    { lptr kp_ = kp0 + sl_cur; KLOAD2(0, kp_); KLOAD2(1, kp_); KLOAD2(2, kp_); KLOAD2(3, kp_); }
    XWAIT_BAR(2);
#define PKW(P, B) cvtpk(P[B], P[B + 1])
#define PAF(k) __builtin_bit_cast(bf16x8, pw##k)
#define VFR(i) (bf16x8){vlo[i][0], vlo[i][1], vlo[i][2], vlo[i][3], vhi[i][0], vhi[i][1], vhi[i][2], vhi[i][3]}
#define PIN(x) asm volatile("" : "+v"(x))
#define MX3(a, b, c) __builtin_fmaxf(__builtin_fmaxf((a), (b)), (c))
#define GAPA(MF, A0, A1, A2, A3, W0, W1, PW) do { MF; sacc += A0; sacc += A1; sacc += A2; sacc += A3; PIN(sacc); W0; W1; PIN(PW); SBAR(); } while (0)
#define EX(v) __builtin_amdgcn_exp2f(v)
#define GAPB(MF, X, B) do { MF; X[B] = EX(X[B]); X[B + 1] = EX(X[B + 1]); X[B + 2] = EX(X[B + 2]); X[B + 3] = EX(X[B + 3]); PIN(X); SBAR(); } while (0)
#define VRD(i) do { vlo[i] = vtr(vp_ + (((i) >> 2) * 4096 + ((i) & 3) * 1024)); vhi[i] = vtr(vp_ + (((i) >> 2) * 4096 + ((i) & 3) * 1024 + 512)); } while (0)
#define KRD(G, j) do { if (G) { KLOAD2(j, kp0 + sl_next); SBAR(); } } while (0)
#define STEP(C0, C1, P0, P1, MWC, i, GK, GV, GL) do { SBAR(); \
    if (MODE == A_DSA) { if ((i) + 2 < NT) MWC##n = mwp[(size_t)TILE((i) + 2) * SEQ * 2]; }        \
    const lptr vp_ = vp0 + sl_prev; \
    VRD(0); SBAR(); float sacc = (P0[0] + P0[1]); \
    GAPA(C0 = MFMA32(kf[0], qr[0], CINIT), P0[2], P0[3], P0[4], P0[5],     pw0[0] = PKW(P0, 0), pw0[1] = PKW(P0, 2), pw0); \
    VRD(4); SBAR(); GAPA(C1 = MFMA32(kf[1], qr[0], CINIT), P0[6], P0[7], P0[8], P0[9],     pw0[2] = PKW(P0, 4), pw0[3] = PKW(P0, 6), pw0); \
    VRD(1); SBAR(); GAPA(C0 = MFMA32(kf[2], qr[1], C0),   P0[10], P0[11], P0[12], P0[13], pw1[0] = PKW(P0, 8), pw1[1] = PKW(P0, 10), pw1); \
    VRD(5); SBAR(); GAPA(C1 = MFMA32(kf[3], qr[1], C1),   P0[14], P0[15], P1[0], P1[1],   pw1[2] = PKW(P0, 12), pw1[3] = PKW(P0, 14), pw1); \
    VRD(2); SBAR(); GAPA(C0 = MFMA32(kf[4], qr[2], C0),   P1[2], P1[3], P1[4], P1[5],     pw2[0] = PKW(P1, 0), pw2[1] = PKW(P1, 2), pw2); \
    VRD(6); SBAR(); GAPA(C1 = MFMA32(kf[5], qr[2], C1),   P1[6], P1[7], P1[8], P1[9],     pw2[2] = PKW(P1, 4), pw2[3] = PKW(P1, 6), pw2); \
    VRD(3); SBAR(); GAPA(C0 = MFMA32(kf[6], qr[3], C0),   P1[10], P1[11], P1[12], P1[13], pw3[0] = PKW(P1, 8), pw3[1] = PKW(P1, 10), pw3); \
    VRD(7); SBAR(); GAPA(C1 = MFMA32(kf[7], qr[3], C1),   P1[14], P1[15], 0.f, 0.f,       pw3[2] = PKW(P1, 12), pw3[3] = PKW(P1, 14), pw3); \
    l_reg += sacc; \
    if (GK) { DMA_K((i) + 3, sl_cur); } if (GV) { DMA_V((i) + 1, sl_next); } \
    APPLY(C0, C1, i, MWC); \
    { float a = MX3(C0[0], C0[1], C1[0]), b_ = MX3(C0[2], C0[3], C1[1]); a = MX3(a, C1[2], C1[3]); \
      _Pragma("unroll") for (int r = 4; r < 16; r += 4) { a = MX3(a, C0[r], C0[r + 1]); b_ = MX3(b_, C0[r + 2], C0[r + 3]); a = MX3(a, C1[r], C1[r + 1]); b_ = MX3(b_, C1[r + 2], C1[r + 3]); } \
      float rm = __builtin_fmaxf(a, b_); { auto rr = __builtin_amdgcn_permlane32_swap(__float_as_uint(rm), __float_as_uint(rm), false, false); rm = __builtin_fmaxf(__uint_as_float(rr[0]), __uint_as_float(rr[1])); } \
      resc = false; \
      if (__builtin_expect(__any(rm > (float)THRL), 0)) { const float dl = __builtin_fmaxf(rm, 0.f); mhat += dl; msh += dl; \
        _Pragma("unroll") for (int r = 0; r < 16; ++r) { negm[r] -= dl; C0[r] -= dl; C1[r] -= dl; }        \
        const float f = __builtin_amdgcn_exp2f(-dl); l_reg *= f; if (hi == 0) { int r32_o = r32; asm volatile("" : "+v"(r32_o)); wsf[r32_o] = f; } resc = true; } } \
    SBAR(); \
    GAPB(o[0] = MFMA32(PAF(0), VFR(0), o[0]), C0, 0); \
    GAPB(o[1] = MFMA32(PAF(0), VFR(4), o[1]), C0, 4); \
    KRD(GL, 0); GAPB(o[0] = MFMA32(PAF(1), VFR(1), o[0]), C0, 8); \
    KRD(GL, 1); GAPB(o[1] = MFMA32(PAF(1), VFR(5), o[1]), C0, 12); \
    KRD(GL, 2); GAPB(o[0] = MFMA32(PAF(2), VFR(2), o[0]), C1, 0); \
    KRD(GL, 3); GAPB(o[1] = MFMA32(PAF(2), VFR(6), o[1]), C1, 4); \
    GAPB(o[0] = MFMA32(PAF(3), VFR(3), o[0]), C1, 8); \
    GAPB(o[1] = MFMA32(PAF(3), VFR(7), o[1]), C1, 12); \
    if (MODE == A_FOX) {       \
        const int T_ = TILE(i); const float fk = T_ > 0 ? F2[T_ * KVBLK - 1] : 0.f; \
        const bool dead = T_ > 0 && (smax - fk < msh - 152.0f);        \
        const bool wd_ = __all(dead); wdead = wdead || wd_; \
        if (lane == 0) exflag[((i) & 1) * 8 + wid] = wd_ ? 1u : 0u; } \
    } while (0)
#define STEP_SKIP(C0, C1, MWC, i, GK, GV, GL) do { SBAR(); \
    if (MODE == A_DSA) { if ((i) + 2 < NT) MWC##n = mwp[(size_t)TILE((i) + 2) * SEQ * 2]; } \
    if (GK) { DMA_K((i) + 3, sl_cur); } if (GV) { DMA_V((i) + 1, sl_next); } \
    if (GL) { KLOAD2(0, kp0 + sl_next); KLOAD2(1, kp0 + sl_next); KLOAD2(2, kp0 + sl_next); KLOAD2(3, kp0 + sl_next); } \
    _Pragma("unroll") for (int r = 0; r < 16; ++r) { C0[r] = 0.f; C1[r] = 0.f; } \
    resc = false; \
    if (MODE == A_FOX) { if (lane == 0) exflag[((i) & 1) * 8 + wid] = wdead ? 1u : 0u; } \
    } while (0)
#define LIVE(i) (!(TILE(i) * KVBLK > qlast_w) && !wdead)
#define ENDW(i) do { if ((i) + 3 < NT) { XWAIT_BAR(2); } else if ((i) + 2 < NT) { XWAIT_BAR(1); } else { XWAIT_BAR(0); }        \
        if (MODE == A_FOX) { unsigned alld = 1u; _Pragma("unroll") for (int w = 0; w < 8; ++w) alld &= exflag[((i) & 1) * 8 + w]; if (alld) stop = true; } } while (0)
#define DRAIN(P0, P1) do { float sacc = P0[0] + P0[1]; _Pragma("unroll") for (int r = 2; r < 16; ++r) sacc += P0[r]; _Pragma("unroll") for (int r = 0; r < 16; ++r) sacc += P1[r]; l_reg += sacc; \
        pw0 = (u32x4){PKW(P0, 0), PKW(P0, 2), PKW(P0, 4), PKW(P0, 6)}; pw1 = (u32x4){PKW(P0, 8), PKW(P0, 10), PKW(P0, 12), PKW(P0, 14)}; \
        pw2 = (u32x4){PKW(P1, 0), PKW(P1, 2), PKW(P1, 4), PKW(P1, 6)}; pw3 = (u32x4){PKW(P1, 8), PKW(P1, 10), PKW(P1, 12), PKW(P1, 14)}; \
        const lptr vp_ = vp0 + sl_cur; _Pragma("unroll") for (int i_ = 0; i_ < 8; ++i_) VRD(i_); \
        o[0] = MFMA32(PAF(0), VFR(0), o[0]); o[1] = MFMA32(PAF(0), VFR(4), o[1]); o[0] = MFMA32(PAF(1), VFR(1), o[0]); o[1] = MFMA32(PAF(1), VFR(5), o[1]); \
        o[0] = MFMA32(PAF(2), VFR(2), o[0]); o[1] = MFMA32(PAF(2), VFR(6), o[1]); o[0] = MFMA32(PAF(3), VFR(3), o[0]); o[1] = MFMA32(PAF(3), VFR(7), o[1]); } while (0)
    unsigned mwAn = 0u, mwBn = 0u;
    int i = 1, ilast = NT - 1;
    bool pzero = !LIVE(0);
    for (; i + 1 < NT; i += 2) {
        ALIGN_LOOP();
        { const bool lc_ = LIVE(i);
          if (MODE != A_FOX || lc_ || !pzero) STEP(pB0, pB1, pA0, pA1, mwB, i, (i + 3 < NT), (i + 1 < NT), (i + 1 < NT)); else STEP_SKIP(pB0, pB1, mwB, i, (i + 3 < NT), (i + 1 < NT), (i + 1 < NT));
          pzero = !lc_; }
        ENDW(i);     RESC(); mwB = mwBn; ROT();
        { const bool lc_ = LIVE(i + 1);
          if (MODE != A_FOX || lc_ || !pzero) STEP(pA0, pA1, pB0, pB1, mwA, i + 1, (i + 4 < NT), (i + 2 < NT), (i + 2 < NT)); else STEP_SKIP(pA0, pA1, mwA, i + 1, (i + 4 < NT), (i + 2 < NT), (i + 2 < NT));
          pzero = !lc_; }
        ENDW(i + 1); RESC(); mwA = mwAn; ROT();
        if (stop) {
            ilast = i + 2; XWAIT_BAR(0); break; }
    }
    STEP(pB0, pB1, pA0, pA1, mwB, ilast, false, false, false); RESC(); DRAIN(pB0, pB1);
    unsigned nx_ = 0u; const bool pop_ = (tid == 0);
    if (pop_) nx_ = __hip_atomic_fetch_add(qctr, 1u, RLX_AGENT);
    { auto rr = __builtin_amdgcn_permlane32_swap(__float_as_uint(l_reg), __float_as_uint(l_reg), false, false); l_reg = __uint_as_float(rr[0]) + __uint_as_float(rr[1]); }
    if (hi == 0) wsf[32 + r32] = l_reg;
    asm volatile("s_waitcnt lgkmcnt(0)" ::: "memory");
    float rli[16];
#pragma unroll
    for (int r = 0; r < 16; ++r) rli[r] = __builtin_amdgcn_rcpf(wsf[32 + crow(r, hi)]);
    bf16* Ow = ACT + (rowbase + q0 + wid * QBLK) * ACTP + so * 64;
    {
        LAS bf16* stg = (LAS bf16*)(shm + XL_OST) + wid * 2048;
#pragma unroll
        for (int r = 0; r < 16; ++r) { const int orow = crow(r, hi);
#pragma unroll
            for (int d0 = 0; d0 < 2; ++d0) stg[orow * 64 + d0 * 32 + r32] = (bf16)(cvtpk(o[d0][r] * rli[r], 0.f) & 0xffffu); }
        asm volatile("s_waitcnt lgkmcnt(0)" ::: "memory");
#pragma unroll
        for (int i_ = 0; i_ < 4; ++i_) { const int row = i_ * 8 + (lane >> 3), ch = lane & 7; const u32x4 v = *(const LAS u32x4*)(stg + row * 64 + ch * 8); *(u32x4*)(Ow + (long)row * ACTP + ch * 8) = v; }
    }
    if (pop_) *nslot = nx_;
    asm volatile("s_waitcnt lgkmcnt(0)\n\ts_barrier" ::: "memory");
#undef CINIT
#undef LIVE
#undef STEP_SKIP
#undef TILE
#undef DMA_K
#undef DMA_V
#undef XWAIT_BAR
#undef SBAR
#undef APPLY
#undef RESC
#undef ROT
#undef KLOAD2
#undef PKW
#undef PAF
#undef VFR
#undef PIN
#undef MX3
#undef GAPA
#undef EX
#undef GAPB
#undef VRD
#undef KRD
#undef STEP
#undef ENDW
#undef DRAIN
}

constexpr int SEL_CAP = 128, SEL_LW = 132, SEL_HW = 257;
constexpr unsigned SEL_Z = 0x80000000u;
constexpr int SEL_PB = 5903, SEL_NB = 986;
constexpr int SEL_K = 0, SEL_HIST = 65536, SEL_LIST = SEL_HIST + 32768, SEL_ST = SEL_LIST + 64 * SEL_LW * 4, SEL_PS = SEL_ST + 12 * 256, SEL_END = SEL_PS + 64 * 8 * 4;
static_assert(SEL_ST >= SEL_HIST + 64 * SEL_HW * 4, "select LDS map");
static_assert(SEL_END <= MISC_OFF, "select LDS");
__device__ __forceinline__ unsigned sortkey(float s) { const unsigned u = __float_as_uint(s); return u ^ ((unsigned)((int)u >> 31) | 0x80000000u); }
typedef unsigned long long u64;
__device__ __forceinline__ float relu_(float x) { const int b = __float_as_int(x); return __int_as_float(b > 0 ? b : 0); }
__device__ __forceinline__ unsigned sel_shift(unsigned W) { const unsigned lg = W <= 1u ? 0u : 32u - (unsigned)__builtin_clz(W - 1u); return lg > 8u ? lg - 8u : 0u; }

__device__ __forceinline__ void select_unit(int b, int qi, const bf16* ACT, const bf16* KVH, const float* WI, unsigned* maskw_b, LAS char* shm, gu32* qctr, volatile LAS unsigned* nslot) {
    int tid = otid();
    const int lane = tid & 63, r32 = lane & 31, hi = lane >> 5; const int wid = __builtin_amdgcn_readfirstlane(tid >> 6);
    const int qsub = wid & 1, kph = wid >> 1;
    const long rowbase = (long)b * SEQ; const int q0 = qi * 64;
    const int qloc = qsub * 32 + r32, qabs = q0 + qloc;
    const int NTs = qi + 1, nsteps = (NTs + 3) >> 2;
    const unsigned lds0 = (unsigned)(uintptr_t)shm;
    LAS unsigned* hist = (LAS unsigned*)(shm + SEL_HIST);
    LAS unsigned* mlds = (LAS unsigned*)(shm + SEL_HIST);
    LAS unsigned* list = (LAS unsigned*)(shm + SEL_LIST);
    LAS unsigned* st_lo = (LAS unsigned*)(shm + SEL_ST); LAS unsigned* st_wd = st_lo + 64; LAS unsigned* st_sh = st_lo + 128; LAS unsigned* st_need = st_lo + 192;
    LAS unsigned* st_state = st_lo + 256; LAS unsigned* st_ilo = st_lo + 320; LAS unsigned* st_iwd = st_lo + 384; LAS unsigned* st_cnt = st_lo + 448; LAS unsigned* st_mode = st_lo + 512; LAS unsigned* flag = st_lo + 576;
    LAS unsigned* psum = (LAS unsigned*)(shm + SEL_PS);
    const bf16* Qw = ACT + (rowbase + qabs) * ACTP + A_IQ * 64;
    bf16x8 qf[4][4];
#pragma unroll
    for (int h = 0; h < 4; ++h)
#pragma unroll
        for (int d0 = 0; d0 < 4; ++d0) qf[h][d0] = *reinterpret_cast<const bf16x8*>(&Qw[h * 64 + d0 * 16 + hi * 8]);
    const f32x4 wv = *(const f32x4*)(WI + (size_t)(rowbase + qabs) * 4);
    const bf16* ksrc = KVH + ((size_t)KV_IK * M + rowbase + lane) * 64 + wid * 8;
    const unsigned kdst = lds0 + SEL_K + wid * 1024;
    lptr kbase = (lptr)shm + SEL_K;
#define SEL_DMA(s, slot) do { _Pragma("unroll") for (int j_ = 0; j_ < 4; ++j_) { const int t_ = 4 * (s) + j_; if (t_ < NTs) glds16(ksrc + (long)t_ * 64 * 64, (unsigned)__builtin_amdgcn_readfirstlane(kdst + (slot) + j_ * 8192)); } } while (0)
    LOCAL_I(c256, 256);
    if (tid < 64) { const bool all = (q0 + tid) < c256; st_lo[tid] = 0u; st_wd[tid] = 0u; st_sh[tid] = 0u; st_need[tid] = (unsigned)c256; st_state[tid] = all ? 2u : 0u; st_cnt[tid] = 0u; }
    for (int i = tid; i < (SEL_ST - SEL_HIST) / 4; i += 512) hist[i] = 0u;
    if (tid == 0) flag[0] = (q0 + 63 < 256) ? 1u : 0u;
    __syncthreads();
    bool fin = flag[0] != 0u;
    for (int pass = 0; pass < 14; ++pass) {
        if (pass == 13) fin = true;
        const unsigned lo = st_lo[qloc], wd = st_wd[qloc], shv = st_sh[qloc];
        const bool active = st_state[qloc] == 0u;
        const unsigned rwid = active ? wd : 0u;
        const unsigned upk = (lo + wd < lo) ? 0xffffffffu : lo + wd;
        LAS unsigned* hrow = hist + qloc * SEL_HW;
        const int kind = fin ? 2 : pass == 0 ? 0 : 1;
#define SEL_COLLECT(kv_, key_) do { \
            if (st_state[qloc] == 3u) __hip_atomic_fetch_or(&list[qloc * SEL_LW + ((kv_) >> 5)], 1u << ((kv_) & 31), __ATOMIC_RELAXED, __HIP_MEMORY_SCOPE_WORKGROUP); \
            else { const unsigned e = __hip_atomic_fetch_add(&st_cnt[qloc], 1u, __ATOMIC_RELAXED, __HIP_MEMORY_SCOPE_WORKGROUP); if (e < (unsigned)SEL_CAP) list[qloc * SEL_LW + e] = (((key_) - lo) << 12) | (unsigned)(4095 - (kv_)); } } while (0)
#define SEL_BIN0(key_, bin_) \
            int bp_ = (int)((key_) >> 19) - cPB; bp_ = bp_ < 0 ? 0 : bp_ > c351 ? c351 : bp_; \
            int bn_ = (int)((key_) >> 20) - cNB; bn_ = bn_ < 0 ? 0 : bn_ > c158 ? c158 : bn_; \
            const int bin_ = (key_) > SEL_Z ? c160 + bp_ : (key_) == SEL_Z ? c159 : bn_;
#define SEL_TILE(KIND, DIAG) do { \
            int t_o = t; asm volatile("" : "+s"(t_o));        \
            LOCAL_I(c351, 351); LOCAL_I(c158, 158); LOCAL_I(c159, 159); LOCAL_I(c160, 160); LOCAL_I(cPB, SEL_PB); LOCAL_I(cNB, SEL_NB);        \
            int kvb = t_o * 64 + 4 * hi; asm volatile("" : "+v"(kvb));        \
            unsigned cw = 0u;                                 \
            if (DIAG) { const int ql_ = qabs - kvb; _Pragma("unroll") for (int i = 31; i >= 0; --i) asm("v_cmp_ge_i32 vcc, %1, %2\n\tv_addc_co_u32 %0, vcc, %0, %0, vcc" : "+v"(cw) : "v"(ql_), "n"((i & 3) + 8 * ((i & 15) >> 2) + 32 * (i >> 4)) : "vcc"); } \
            unsigned word = 0u; \
            lptr kb = kbase + slot + kph * 8192 + hi * 1024 + r32 * 16; \
            _Pragma("unroll") for (int half = 0; half < 2; ++half) { \
                bf16x8 kf[4]; \
                _Pragma("unroll") for (int d0 = 0; d0 < 4; ++d0) kf[d0] = *(const LAS bf16x8*)(kb + d0 * 2048 + half * 512); \
                f32x16 sc = f32x16{}; \
                _Pragma("unroll") for (int h = 0; h < 4; ++h) { \
                    f32x16 d = f32x16{}; \
                    _Pragma("unroll") for (int d0 = 0; d0 < 4; ++d0) d = MFMA32(kf[d0], qf[h][d0], d); \
                    const float w = wv[h]; \
                    _Pragma("unroll") for (int r = 0; r < 16; ++r) sc[r] += w * relu_(d[r]); \
                } \
                if (KIND == 2) { \
                    unsigned dmin = 0xffffffffu; \
                    _Pragma("unroll") for (int r = 15; r >= 0; --r) {         \
                        const unsigned key = sortkey(sc[r]); \
                        asm("v_cmp_le_u32 vcc, %2, %1\n\tv_addc_co_u32 %0, vcc, %0, %0, vcc" : "+v"(word) : "v"(key), "v"(upk) : "vcc"); \
                        dmin = min(dmin, key - lo); \
                    } \
                    if (dmin < wd) {                                          \
                        _Pragma("unroll") for (int r = 0; r < 16; ++r) { \
                            const int kv = kvb + (r & 3) + 8 * (r >> 2) + 32 * half; const unsigned key = sortkey(sc[r]); \
                            if ((key - lo) < wd && (!(DIAG) || __builtin_amdgcn_ubfe(cw, 16 * half + r, 1))) SEL_COLLECT(kv, key); \
                        } \
                    } \
                } else if (KIND == 0) {                                        \
                    _Pragma("unroll") for (int r = 0; r < 16; ++r) { \
                        const unsigned key = sortkey(sc[r]); \
                        SEL_BIN0(key, bin) \
                        const unsigned one = (DIAG) ? __builtin_amdgcn_ubfe(cw, 16 * half + r, 1) : 1u; \
                        __hip_atomic_fetch_add(&hrow[bin >> 1], one << (16 * (bin & 1)), __ATOMIC_RELAXED, __HIP_MEMORY_SCOPE_WORKGROUP); \
                    } \
                } else { \
                    _Pragma("unroll") for (int r = 0; r < 16; ++r) { \
                        const unsigned key = sortkey(sc[r]); \
                        const unsigned dv = key - lo;        \
                        const unsigned one = (DIAG) ? __builtin_amdgcn_ubfe(cw, 16 * half + r, 1) : 1u; \
                        if (dv < rwid) { const unsigned g = dv >> shv; __hip_atomic_fetch_add(&hrow[g >> 1], one << (16 * (g & 1u)), __ATOMIC_RELAXED, __HIP_MEMORY_SCOPE_WORKGROUP); } \
                    } \
                } \
            } \
            if (KIND == 2) { word = (word >> 16) | (word << 16); if (DIAG) word &= cw; mlds[(t_o * 64 + qloc) * 2 + hi] = word; } \
        } while (0)
#define SEL_SWEEP(KIND) do { \
        SEL_DMA(0, 0); \
        ATT_WAIT_BAR(); \
        for (int s = 0; s < nsteps; ++s) { \
            ALIGN_LOOP(); \
            const int slot = (s & 1) * 32768; \
            if (s + 1 < nsteps) SEL_DMA(s + 1, 32768 - slot); \
            const int t = 4 * s + kph; \
            if (t < qi) SEL_TILE(KIND, 0); \
            else if (t == qi) SEL_TILE(KIND, 1); \
            ATT_WAIT_BAR(); \
        } } while (0)
        if (kind == 2) { SEL_SWEEP(2);
            if (SELP == 2) { __syncthreads(); if (tid < 64) st_cnt[tid] = 0u; __syncthreads(); SEL_SWEEP(2); } }
        else if (kind == 0) { SEL_SWEEP(0); }
        else { SEL_SWEEP(1);
            if (SELP == 3) { __syncthreads(); for (int i = tid; i < 64 * SEL_HW; i += 512) hist[i] = 0u; __syncthreads(); SEL_SWEEP(1); } }
#undef SEL_SWEEP
#undef SEL_TILE
#undef SEL_BIN0
#undef SEL_COLLECT
        if (fin) break;
        {
            const int row = tid >> 3, part = tid & 7;
            unsigned sacc = 0u;
#pragma unroll
            for (int w = 0; w < 32; ++w) { const unsigned x = hist[row * SEL_HW + part * 32 + w]; sacc += (x & 0xffffu) + (x >> 16); }
            psum[row * 8 + part] = sacc;
        }
        __syncthreads();
        if (tid < 64) {
            const int row = tid;
            unsigned state = st_state[row];
            if (state == 0u) {
                unsigned need = st_need[row], cum = 0u; int part = 7;
                for (; part > 0; --part) { const unsigned c = psum[row * 8 + part]; if (cum + c >= need) break; cum += c; }
                int dstar = part * 64; unsigned cbin = 0u;
                for (int w = 31; w >= 0; --w) {
                    const unsigned x = hist[row * SEL_HW + part * 32 + w]; const unsigned co = x >> 16, ce = x & 0xffffu;
                    if (cum + co >= need) { dstar = part * 64 + 2 * w + 1; cbin = co; break; } cum += co;
                    if (cum + ce >= need) { dstar = part * 64 + 2 * w; cbin = ce; break; } cum += ce;
                }
                need -= cum;
                unsigned L, W;
                LOCAL_I(sPB, SEL_PB); LOCAL_I(sNB, SEL_NB);
                if (kind == 0) {
                    if (dstar >= 160) { const int bp = dstar - 160;
                        if (bp == 0) { L = SEL_Z + 1u; W = ((unsigned)(SEL_PB + 1) << 19) - L; }
                        else if (bp == 351) { L = (unsigned)(SEL_PB + 351) << 19; W = 0u - L; }
                        else { L = (unsigned)(sPB + bp) << 19; W = 1u << 19; } }
                    else if (dstar == 159) { L = SEL_Z; W = 1u; }
                    else { const int bn = dstar;
                        if (bn == 0) { L = 0u; W = (unsigned)(SEL_NB + 1) << 20; }
                        else if (bn == 158) { L = (unsigned)(SEL_NB + 158) << 20; W = SEL_Z - L; }
                        else { L = (unsigned)(sNB + bn) << 20; W = 1u << 20; } }
                } else {
                    const unsigned lo_r = st_lo[row], wd_r = st_wd[row], sh_r = st_sh[row];
                    L = lo_r + ((unsigned)dstar << sh_r); W = min(1u << sh_r, lo_r + wd_r - L);
                }
                if (cbin == need) { state = 2u; W = 0u; }
                else if (cbin <= (unsigned)SEL_CAP && W <= (1u << 20)) state = 1u;
                else if (W == 1u) state = 3u;
                st_lo[row] = L; st_wd[row] = W; st_sh[row] = sel_shift(W);
                st_need[row] = need; st_state[row] = state;
            }
            const bool anyp = __any(state == 0u);
            if (tid == 0) flag[0] = anyp ? 0u : 1u;
        }
        __syncthreads();
        for (int i = tid; i < 64 * SEL_HW; i += 512) hist[i] = 0u;
        __syncthreads();
        fin = flag[0] != 0u;
    }
    unsigned nx_ = 0u; const bool pop_ = (tid == 0);
    if (pop_) nx_ = __hip_atomic_fetch_add(qctr, 1u, RLX_AGENT);
    {
        const int row = tid >> 3, part = tid & 7;
        const unsigned stt = st_state[row], need = st_need[row];
        const LAS unsigned* lr = list + row * SEL_LW;
        unsigned bcnt = 0u;
        if (stt == 3u) {
#pragma unroll
            for (int w = 0; w < 16; ++w) bcnt += (unsigned)__builtin_popcount(lr[part * 16 + w]);
        }
        psum[row * 8 + part] = bcnt;
        __syncthreads();
        if (stt == 1u) {
            const unsigned n = min(st_cnt[row], (unsigned)SEL_CAP);
            LOCAL_U(c4095, 4095u);
            for (unsigned e = part; e < n; e += 16) {
                const unsigned c0 = lr[e]; const bool has1 = e + 8 < n; const unsigned c1 = has1 ? lr[e + 8] : 0xffffffffu;
                unsigned r0 = 0u, r1 = 0u;
                for (unsigned j = 0; j < n; j += 4) {
                    const u32x4 x = *(const LAS u32x4*)(lr + j);
                    r0 += (x[0] > c0 ? 1u : 0u) + (x[1] > c0 ? 1u : 0u) + (x[2] > c0 ? 1u : 0u) + (x[3] > c0 ? 1u : 0u);
                    r1 += (x[0] > c1 ? 1u : 0u) + (x[1] > c1 ? 1u : 0u) + (x[2] > c1 ? 1u : 0u) + (x[3] > c1 ? 1u : 0u);
                }
#pragma unroll
                for (int w = 0; w < 2; ++w) {
                    const unsigned c = w ? c1 : c0, rank = w ? r1 : r0;
                    if ((w == 0 || has1) && rank < need) {
                        const int kv = (int)(c4095 - (c & c4095)), t = kv >> 6, k32 = kv & 31, half = (kv >> 5) & 1, hi_ = (k32 >> 2) & 1, r = (k32 & 3) + 4 * (k32 >> 3);
                        __hip_atomic_fetch_or(&mlds[(t * 64 + row) * 2 + hi_], 1u << (16 * half + r), __ATOMIC_RELAXED, __HIP_MEMORY_SCOPE_WORKGROUP);
                    }
                }
            }
        } else if (stt == 3u) {
            unsigned before = 0u;
            for (int p = 0; p < part; ++p) before += psum[row * 8 + p];
            for (int w = 0; w < 16 && before < need; ++w) {
                unsigned x = lr[part * 16 + w];
                while (x != 0u && before < need) {
                    const int bit = __builtin_ctz(x); x &= x - 1u; ++before;
                    const int kv = (part * 16 + w) * 32 + bit, t = kv >> 6, k32 = kv & 31, half = (kv >> 5) & 1, hi_ = (k32 >> 2) & 1, r = (k32 & 3) + 4 * (k32 >> 3);
                    __hip_atomic_fetch_or(&mlds[(t * 64 + row) * 2 + hi_], 1u << (16 * half + r), __ATOMIC_RELAXED, __HIP_MEMORY_SCOPE_WORKGROUP);
                }
            }
        }
    }
    __syncthreads();
    for (int i = tid; i < NTs * 128; i += 512) { const int t = i >> 7, rem = i & 127; maskw_b[((size_t)t * SEQ + q0) * 2 + rem] = mlds[i]; }
    if (pop_) *nslot = nx_;
    ATT_WAIT_BAR();
#undef SEL_DMA
}
#undef ATT_WAIT_BAR
#undef MFMA32
}

#define XB_TMO      128
#define XB_XCNT(j)  (256  + 64 * (j))
#define XB_XSUB(j)  (1280 + 64 * (j))
#define XB_XGEN(j)  (2304 + 64 * (j))
#define XB_TOP      3328
#define XB_TOPGEN   3392
#define XCD_BAR_WORDS 3456
#define XB_SPIN_CAP (1u << 18)
__device__ __forceinline__ unsigned xb_ld(unsigned* p)              { return __hip_atomic_load(p, __ATOMIC_RELAXED, __HIP_MEMORY_SCOPE_AGENT); }
__device__ __forceinline__ unsigned xb_add(unsigned* p, unsigned v) { return __hip_atomic_fetch_add(p, v, __ATOMIC_RELAXED, __HIP_MEMORY_SCOPE_AGENT); }
__device__ __forceinline__ unsigned xb_xcc_id() { return (unsigned)__builtin_amdgcn_s_getreg((3 << 11) | 20) & 0xFu; }
#define XB_SPIN(cond, bar) do { unsigned _sp = 0; while (cond) { __builtin_amdgcn_s_sleep(1); \
    if ((++_sp & 255u) == 0u) { if (xb_ld(&(bar)[XB_TMO])) break; if (_sp > XB_SPIN_CAP) { atomicAdd(&(bar)[XB_TMO], 1u); break; } } } } while (0)
struct XcdBarrier { unsigned* bar; unsigned x; volatile LAS unsigned* st; };
__device__ __forceinline__ XcdBarrier xcd_barrier_post(unsigned* bar, volatile LAS unsigned* st) {
    XcdBarrier b; b.bar = bar; b.x = xb_xcc_id(); b.st = st;
    if (otid() == 0) { (void)xb_add(&bar[XB_XCNT(b.x)], 1u); st[2] = b.x; }
    return b;
}
__device__ __forceinline__ void xcd_barrier_complete(unsigned* bar, unsigned x, unsigned& nloc, unsigned& nx) {
    const unsigned G = gridDim.x * gridDim.y * gridDim.z;
    unsigned sum, cnt, mine, sp = 0u;
    for (;;) {
        sum = 0u; cnt = 0u; mine = 0u;
#pragma unroll
        for (unsigned j = 0; j < 16; ++j) { const unsigned c = xb_ld(&bar[XB_XCNT(j)]); sum += c; cnt += (c > 0u) ? 1u : 0u; mine = (j == x) ? c : mine; }
        if (sum == G) break;
        __builtin_amdgcn_s_sleep(1);
        if ((++sp & 255u) == 0u) { if (xb_ld(&bar[XB_TMO])) break; if (sp > XB_SPIN_CAP) { atomicAdd(&bar[XB_TMO], 1u); break; } }
    }
    nloc = mine > 0u ? mine : 1u; nx = cnt > 0u ? cnt : 1u;
}
__device__ __forceinline__ void xcd_barrier(const XcdBarrier& b) {
    asm volatile("s_waitcnt vmcnt(0)" ::: "memory");
    __syncthreads();
    if (otid() == 0) {
        unsigned* bar = b.bar;
        __builtin_amdgcn_s_waitcnt(0);
        unsigned nloc = b.st[0], nx = b.st[1];
        const unsigned bx_ = b.st[2];
        if (nloc == 0u) { xcd_barrier_complete(bar, bx_, nloc, nx); b.st[0] = nloc; b.st[1] = nx; }
        const unsigned old = xb_add(&bar[XB_XSUB(bx_)], 1u);
        const unsigned gen = old / nloc;
        if (old + 1u == (gen + 1u) * nloc) {
            __builtin_amdgcn_fence(__ATOMIC_RELEASE, "agent");
            asm volatile("s_waitcnt vmcnt(0)" ::: "memory");
            const unsigned og = xb_add(&bar[XB_TOP], 1u);
            const unsigned tg = og / nx;
            if (og + 1u == (tg + 1u) * nx) xb_add(&bar[XB_TOPGEN], 1u);
            else XB_SPIN(xb_ld(&bar[XB_TOPGEN]) == tg, bar);
            __builtin_amdgcn_fence(__ATOMIC_ACQUIRE, "agent");
            xb_add(&bar[XB_XGEN(bx_)], 1u);
            asm volatile("s_waitcnt vmcnt(0)" ::: "memory");
        } else {
            XB_SPIN(xb_ld(&bar[XB_XGEN(bx_)]) == gen, bar);
            __builtin_amdgcn_fence(__ATOMIC_ACQUIRE, "agent");
            asm volatile("s_waitcnt vmcnt(0)" ::: "memory");
        }
    }
    __syncthreads();
}

__device__ __forceinline__ float wave_sum(float v) {
#pragma unroll
    for (int o = 1; o < 64; o <<= 1) v += __shfl_xor(v, o);
    return v;
}
__device__ __forceinline__ int win_src_col(int p) {
    const int tile = p >> 8, bj = (p >> 7) & 1, wc = (p >> 5) & 3, j = p & 31, slot = tile * 4 + wc;
    int d = 32 * bj + j;
    const bool rope = (slot >= SL_CQ && slot < SL_FK) || (slot >= SL_CK && slot < SL_FV) || (slot >= SL_IQ && slot <= SL_IK);
    if (rope) { if (d >= 8 && d < 16) d += 24; else if (d >= 32 && d < 40) d -= 24; }
    if (slot < 6) return 0 + 64 * slot + d;
    if (slot < 12) return 1158 + 64 * (slot - 6) + d;
    if (slot < 16) return 2310 + 64 * (slot - 12) + d;
    if (slot < 22) return 384 + 64 * (slot - 16) + d;
    if (slot < 28) return 1542 + 64 * (slot - 22) + d;
    if (slot < 32) return 2566 + 64 * (slot - 28) + d;
    if (slot < 38) return 768 + 64 * (slot - 32) + d;
    if (slot < 44) return 1926 + 64 * (slot - 38) + d;
    if (slot < 48) return 2822 + 64 * (slot - 44) + d;
    if (slot < 52) return 3078 + 64 * (slot - 48) + d;
    if (slot == 52) return 3334 + d;
    if (slot == 53) { if (d < 6) return 1152 + d; if (d >= 8 && d < 12) return 3398 + (d - 8); return -1; }
    return -1;
}
struct CvtJob { const float* W; const float* W2; int ldw; int K; int N; bf16* dst; int dld; int koff; const float* gain; int cmode; };
__device__ __forceinline__ void cvt_item(const CvtJob& J, int item, LAS float* scr, int lane) {
    const int nblk = J.N / 32, kb = item / nblk, nb = item % nblk, k0 = 64 * kb, n0 = 32 * nb;
    const int p = n0 + (lane & 31);
    const float* src = J.W; int col = p;
    if (J.cmode == 1) { src = ((p >> 7) & 1) ? J.W2 : J.W; col = 128 * (p >> 8) + (p & 127); }
    else if (J.cmode == 2) { col = win_src_col(p); }
    float v[32];
    const float* sp = src + (size_t)(k0 + (lane >> 5)) * J.ldw + (col >= 0 ? col : 0);
#pragma unroll
    for (int i = 0; i < 32; ++i) v[i] = sp[(size_t)(2 * i) * J.ldw];
    if (J.gain) { const float* gp = J.gain + k0 + (lane >> 5);
#pragma unroll
        for (int i = 0; i < 32; ++i) v[i] *= gp[2 * i]; }
    if (col < 0) {
#pragma unroll
        for (int i = 0; i < 32; ++i) v[i] = 0.f; }
#pragma unroll
    for (int i = 0; i < 32; ++i) scr[(2 * i + (lane >> 5)) * 33 + (lane & 31)] = v[i];
    asm volatile("s_waitcnt lgkmcnt(0)" ::: "memory");
    const int c = lane & 7;
#pragma unroll
    for (int j = 0; j < 4; ++j) { const int n = (lane >> 3) + 8 * j; const LAS float* s = scr + (8 * c) * 33 + n;
        u32x4 o; o.x = cvtpk(s[0 * 33], s[1 * 33]); o.y = cvtpk(s[2 * 33], s[3 * 33]); o.z = cvtpk(s[4 * 33], s[5 * 33]); o.w = cvtpk(s[6 * 33], s[7 * 33]);
        *(u32x4*)(J.dst + (size_t)(n0 + n) * J.dld + J.koff + k0 + 8 * c) = o; }
    asm volatile("s_waitcnt lgkmcnt(0)" ::: "memory");
}

struct Args { const float* in[24]; float* out; unsigned char* ws; };

struct UpSched {
    pg8::TileOrder T; unsigned wb;
    __device__ bool get(int i, pg8::GUnit& u) const { int pm, pn; if (!T.tile(i, pm, pn)) return false;
        u.a = (unsigned)WS_XB + (unsigned)pm * (256 * 2048); u.b = wb + (unsigned)pn * (256 * 2048); u.lda = 2048; u.ldb = 2048; u.nt = 16; u.pm = pm; u.pn = pn; u.mode = 0; u.ui = i; return true; }
};
struct DownSched {
    pg8::TileOrder T; unsigned wb;
    __device__ bool get(int i, pg8::GUnit& u) const { int pm, pn; if (!T.tile(i, pm, pn)) return false;
        u.a = (unsigned)WS_ACT + (unsigned)pm * (256 * DFF * 2); u.b = wb + (unsigned)pn * (256 * DFF * 2); u.lda = DFF * 2; u.ldb = DFF * 2; u.nt = DFF / 64; u.pm = pm; u.pn = pn; u.mode = 0; return true; }
};
struct WoutSched {
    pg8::TileOrder T; unsigned wb;
    __device__ bool get(int i, pg8::GUnit& u) const { int pm, pn; if (!T.tile(i, pm, pn)) return false;
        u.a = (unsigned)WS_ACT + SL_MERGED * 128 + (unsigned)pm * (256 * ACTP * 2); u.b = wb + (unsigned)pn * (256 * 2048); u.lda = ACTP * 2; u.ldb = 2048; u.nt = 16; u.pm = pm; u.pn = pn; u.mode = 0; return true; }
};
struct MergeSched {
    pg8::TileOrder T; unsigned wbr;
    __device__ bool get(int i, pg8::GUnit& u) const { int pm, pn; if (!T.tile(i / 3, pm, pn)) return false;
        const int x = i % 3; u.pm = pm; u.pn = pn; u.mode = x; u.ldb = 2048;
        const unsigned ko = x == 0 ? 0 : x == 1 ? 384 : 768;
        u.a = (unsigned)WS_ACT + (unsigned)pm * (256 * ACTP * 2) + ko * 2; u.lda = ACTP * 2; u.b = wbr + (unsigned)(pn * 256) * 2048 + ko * 2; u.nt = x == 2 ? 4 : 6;
        return true; }
};

__device__ __forceinline__ int q_pop(gu32* ctr, volatile LAS unsigned* slot) {
    __syncthreads();
    if (otid() == 0) *slot = __hip_atomic_fetch_add(ctr, 1u, RLX_AGENT);
    __syncthreads();
    return (int)*slot;
}

__global__ void __launch_bounds__(512, 2) mega_fwd(Args args) {
    extern __shared__ __attribute__((aligned(16))) unsigned char lds_raw[];
    LAS unsigned char* lds = (LAS unsigned char*)lds_raw;
    volatile LAS unsigned* MISC = (volatile LAS unsigned*)(lds + MISC_OFF);
    {
        const int t0 = threadIdx.x;
        if (t0 < (LDS_BYTES - MISC_OFF) / 4) ((LAS unsigned*)(lds + MISC_OFF))[t0] = 0u;
        __syncthreads();
        if ((t0 & 63) == 0) ((LAS int*)(lds + TIDMAP_OFF))[(unsigned)__builtin_amdgcn_s_getreg((5 << 11) | 4)] = t0 >> 6;
        if (t0 == 0) {
#pragma unroll
            for (int i = 0; i < 24; ++i) ((LAS unsigned long long*)(lds + ARGTAB_OFF))[i] = (unsigned long long)args.in[i];
            ((LAS unsigned long long*)(lds + ARGTAB_OFF))[24] = (unsigned long long)args.out;
        }
        __syncthreads();
    }
    int tid = otid();
    const int lane = tid & 63, wave = __builtin_amdgcn_readfirstlane(tid >> 6);
    const int G = gridDim.x; const int bx = blockIdx.x;
    const int vcu = (G % 8 == 0) ? (bx % 8) * (G / 8) + bx / 8 : bx;
    unsigned char* ws = args.ws;
    gu32* ctl = (gu32*)(ws + WS_CTL);
    XcdBarrier bar = xcd_barrier_post((unsigned*)(ctl + CW_BAR), MISC + 8);

    bf16* XB = (bf16*)(ws + WS_XB); float* SSP = (float*)(ws + WS_SSP); float* LOGF = (float*)(ws + WS_LOGF); float* WI = (float*)(ws + WS_WI);
    unsigned* MASKW = (unsigned*)(ws + WS_MASK); bf16* ACT = (bf16*)(ws + WS_ACT); const bf16* KVH = (const bf16*)(ws + WS_KVH);
    const float* x_in = arg_in(0);

    for (int rep0 = 0; rep0 < ((PROBE == 10) ? 2 : 1); ++rep0) {
        LAS float* scr = (LAS float*)(lds + wave * 16384);
        const int gw = vcu * 8 + wave, NGW = G * 8;
        {
            const int gt = bx * 512 + tid, NGT = G * 512;
            float* par = (float*)(ws + WS_PAR);
            for (int i = gt; i < DEPTH * 4096; i += NGT) {
                const int l = i >> 12, k = i & 4095; float v = 0.f;
                if (k < 384) v = arg_in(10 + (k >> 6))[l * 64 + (k & 63)];
                else if (k < 390) v = arg_in(8)[l * 6 + (k - 384)];
                else if (k == 390) { float gq = 0.f, gk = 0.f; for (int d = 0; d < 64; ++d) { gq = fmaxf(gq, fabsf(arg_in(10)[l * 64 + d])); gk = fmaxf(gk, fabsf(arg_in(11)[l * 64 + d])); } v = 64.0f * C2 * gq * gk * 1.02f; }
                else if (k >= 512 && k < 512 + 3 * DM) v = arg_in(9)[l * 3 * DM + (k - 512)];
                par[i] = v;
            }
            int* posd = (int*)(ws + WS_POS); const int* poss = (const int*)arg_in(1);
            for (int i = gt; i < M; i += NGT) posd[i] = poss[i];
        }
        for (int m = gw; m < M; m += NGW) {
            const GAS f32x4* xr = (const GAS f32x4*)(x_in + (size_t)m * DM) + lane;
            f32x4 v[4]; float s = 0.f;
            GAS u32x2* o8 = (GAS u32x2*)(XB + (size_t)m * DM) + lane;
#pragma unroll
            for (int j = 0; j < 4; ++j) v[j] = xr[64 * j];
#pragma unroll
            for (int j = 0; j < 4; ++j) { u32x2 w; w.x = cvtpk(v[j][0], v[j][1]); w.y = cvtpk(v[j][2], v[j][3]); o8[64 * j] = w;
                const float r0 = bflo(w.x), r1 = bfhi(w.x), r2 = bflo(w.y), r3 = bfhi(w.y); s += (r0 * r0 + r1 * r1) + (r2 * r2 + r3 * r3); }
            s = wave_sum(s);
            if (lane < 16) SSP[(size_t)m * 16 + lane] = lane == 0 ? s : 0.f;
        }
    }

    for (int l = 0; l < DEPTH; ++l) {
        const unsigned wl = (unsigned)WS_W;
        {
            int tid_c = otid();
            const int lane_c = tid_c & 63, wave_c = __builtin_amdgcn_readfirstlane(tid_c >> 6);
            LAS float* scr = (LAS float*)(lds + wave_c * 16384);
            const int gw = vcu * 8 + wave_c, NGW = G * 8;
            unsigned char* wl = ws + WS_W;
            for (int j = 0; j < 10; ++j) {
                CvtJob J; J.W2 = nullptr; J.gain = nullptr; J.koff = 0; J.cmode = 0;
                switch (j) {
                case 0: J.W = arg_in(3) + (size_t)l * DM * DFF; J.W2 = arg_in(4) + (size_t)l * DM * DFF; J.ldw = DFF; J.K = DM; J.N = 2 * DFF; J.dst = (bf16*)(wl + W_GU); J.dld = DM; J.gain = arg_in(2) + l * DM; J.cmode = 1; break;
                case 1: J.W = arg_in(5) + (size_t)l * DFF * DM; J.ldw = DM; J.K = DFF; J.N = DM; J.dst = (bf16*)(wl + W_D); J.dld = DFF; break;
                case 2: J.W = arg_in(7) + (size_t)l * DM * NIN; J.ldw = NIN; J.K = DM; J.N = NWIN; J.dst = (bf16*)(wl + W_IN); J.dld = DM; J.gain = arg_in(6) + l * DM; J.cmode = 2; break;
                case 3: J.W = arg_in(7) + (size_t)l * DM * NIN + 3402; J.ldw = NIN; J.K = DM; J.N = 3 * DM; J.dst = (bf16*)(wl + W_G); J.dld = DM; J.gain = arg_in(6) + l * DM; break;
                case 4: J.W = arg_in(16) + (size_t)l * 384 * DM; J.ldw = DM; J.K = 384; J.N = DM; J.dst = (bf16*)(wl + W_BR); J.dld = DM; J.koff = 0; break;
                case 5: J.W = arg_in(17) + (size_t)l * 384 * DM; J.ldw = DM; J.K = 384; J.N = DM; J.dst = (bf16*)(wl + W_BR); J.dld = DM; J.koff = 384; break;
                case 6: J.W = arg_in(18) + (size_t)l * 256 * DM; J.ldw = DM; J.K = 256; J.N = DM; J.dst = (bf16*)(wl + W_BR); J.dld = DM; J.koff = 768; break;
                case 7: J.W = arg_in(19) + (size_t)l * DM * DM; J.ldw = DM; J.K = DM; J.N = DM; J.dst = (bf16*)(wl + W_OUT); J.dld = DM; break;
                case 8: J.W = arg_in(21) + (size_t)l * DM * DFF; J.W2 = arg_in(22) + (size_t)l * DM * DFF; J.ldw = DFF; J.K = DM; J.N = 2 * DFF; J.dst = (bf16*)(wl + W_GU2); J.dld = DM; J.gain = arg_in(20) + l * DM; J.cmode = 1; break;
                default: J.W = arg_in(23) + (size_t)l * DFF * DM; J.ldw = DM; J.K = DFF; J.N = DM; J.dst = (bf16*)(wl + W_D2); J.dld = DFF; break;
                }
                const int nitems = (J.K / 64) * (J.N / 32);
                for (int it = gw; it < nitems; it += NGW) cvt_item(J, it, scr, lane_c);
            }
        }
        xcd_barrier(bar);
#define OBX() ({ int _b = blockIdx.x; asm volatile("" : "+s"(_b)); _b; })
#define NREP(k) ((PROBE == (k)) ? 2 : 1)
        for (int rep = 0; rep < NREP(1); ++rep) {
            UpSched S; S.T.init(M / 256, 22, G, OBX()); S.wb = wl + (unsigned)W_GU;
            pg8::EpiUp E{ws};
            pg8::rowq_table(lds, ws, S);
            pg8::gemm_phase(lds, ws, S, E);
            xcd_barrier(bar);
        }
        for (int rep = 0; rep < NREP(2); ++rep) {
            DownSched S; S.T.init(M / 256, 4, G, OBX()); S.wb = wl + (unsigned)W_D;
            pg8::EpiRes E{ws, nullptr, rep == NREP(2) - 1 ? 0.5f : 0.0f};
            pg8::gemm_phase(lds, ws, S, E);
            xcd_barrier(bar);
        }
        for (int rep = 0; rep < NREP(3); ++rep) {
            UpSched S; S.T.init(M / 256, 26, G, OBX()); S.wb = wl + (unsigned)W_IN;
            pg8::EpiWin E{ws, l};
            pg8::rowq_table(lds, ws, S);
            pg8::gemm_phase(lds, ws, S, E);
            xcd_barrier(bar);
        }
        for (int rep = 0; rep < NREP(4); ++rep) {
            gu32* qc = ctl + CW_Q + 64 * (l * 8 + 0 + 4 * rep);
            for (int u = q_pop(qc, MISC + 16); u < 512; u = (int)MISC[17]) {
                const int qi = 63 - (u >> 3), b = u & 7;
                att::select_unit(b, qi, ACT, KVH, WI, MASKW + (size_t)b * 64 * SEQ * 2, (LAS char*)lds, qc, MISC + 17);
            }
            if (rep + 1 < NREP(4)) xcd_barrier(bar);
        }
        for (int rep = 0; rep < NREP(5); ++rep) {
            gu32* qc = ctl + CW_Q + 64 * (l * 8 + 1 + 4 * rep);
            const bool real = rep == NREP(5) - 1;
            for (int u = q_pop(qc, MISC + 16); u < 768; u = (int)MISC[17]) {
                const int qb = 15 - u / 48, bh = u % 48, b = bh / 6, h = bh % 6;
                att::attn_unit_x<att::A_FOX, 8>(b, SL_FQ + h, KV_FK + h, KV_FV + h, real ? SL_FQ + h : 35, qb, ACT, KVH, LOGF + (size_t)bh * SEQ, nullptr, ((const float*)(ws + WS_PAR))[l * 4096 + 390], (LAS char*)lds, qc, MISC + 17);
            }
            xcd_barrier(bar);
        }
        for (int rep = 0; rep < NREP(6); ++rep) {
            gu32* qc = ctl + CW_Q + 64 * (l * 8 + 2 + 4 * rep);
            const bool real = rep == NREP(6) - 1;
            for (int u = q_pop(qc, MISC + 16); u < 512; u = (int)MISC[17]) {
                const int qb = 15 - u / 32, bh = u % 32, b = bh / 4, h = bh % 4;
                att::attn_unit_x<att::A_DSA, 8>(b, SL_CQ + h, KV_CK + h, KV_CV + h, real ? SL_CQ + h : 35, qb, ACT, KVH, nullptr, MASKW + (size_t)b * 64 * SEQ * 2, 0.f, (LAS char*)lds, qc, MISC + 17);
            }
            if (rep + 1 < NREP(6)) xcd_barrier(bar);
        }
        for (int rep = 0; rep < NREP(7); ++rep) {
            gu32* qc = ctl + CW_Q + 64 * (l * 8 + 3 + 4 * rep);
            const bool real = rep == NREP(7) - 1;
            for (int u = q_pop(qc, MISC + 16); u < 768; u = (int)MISC[17]) {
                const int qb = 15 - u / 48, bh = u % 48, b = bh / 6, h = bh % 6;
                att::attn_unit<att::A_SB>(b, SL_SQ + h, KV_SK + h, KV_SV + h, real ? SL_SQ + h : 35, qb, ACT, KVH, nullptr, nullptr, 0.f, (LAS char*)lds, qc, MISC + 17);
            }
            xcd_barrier(bar);
        }
        for (int rep = 0; rep < NREP(8); ++rep) {
            MergeSched S; S.T.init(M / 256, 4, G, OBX()); S.wbr = wl + (unsigned)W_BR;
            pg8::EpiMerge E{ws};
            pg8::gemm_phase(lds, ws, S, E);
            xcd_barrier(bar);
        }
        for (int rep = 0; rep < NREP(9); ++rep) {
            WoutSched S; S.T.init(M / 256, 4, G, OBX()); S.wb = wl + (unsigned)W_OUT;
            pg8::EpiRes E{ws, nullptr, rep == NREP(9) - 1 ? 1.0f : 0.0f};
            pg8::gemm_phase(lds, ws, S, E);
            xcd_barrier(bar);
        }
        {
            UpSched S; S.T.init(M / 256, 22, G, OBX()); S.wb = wl + (unsigned)W_GU2;
            pg8::EpiUp E{ws};
            pg8::rowq_table(lds, ws, S);
            pg8::gemm_phase(lds, ws, S, E);
        }
        xcd_barrier(bar);
        {
            DownSched S; S.T.init(M / 256, 4, G, OBX()); S.wb = wl + (unsigned)W_D2;
            pg8::EpiRes E{ws, l + 1 == DEPTH ? (float*)arg_in(24) : nullptr, 0.5f};
            pg8::gemm_phase(lds, ws, S, E);
        }
        if (l + 1 < DEPTH) xcd_barrier(bar);
    }
}

extern "C" void kernel_launch(void* const* d_in, const int* in_sizes, int n_in, void* d_out, int out_size, void* d_ws, size_t ws_size, hipStream_t stream) {
    static int grid = 0;
    if (grid == 0) {
        if (n_in != 24 || out_size != M * DM || ws_size < WS_END) { fprintf(stderr, "kernel_launch: unexpected shapes (n_in %d out %d ws %zu, need %zu)\n", n_in, out_size, ws_size, (size_t)WS_END); grid = -1; return; }
        int dev = 0, cus = 0, per_cu = 0;
        if (hipGetDevice(&dev) != hipSuccess || hipDeviceGetAttribute(&cus, hipDeviceAttributeMultiprocessorCount, dev) != hipSuccess) { grid = -1; return; }
        if (hipFuncSetAttribute((const void*)mega_fwd, hipFuncAttributeMaxDynamicSharedMemorySize, LDS_BYTES) != hipSuccess) { fprintf(stderr, "kernel_launch: hipFuncSetAttribute failed\n"); grid = -1; return; }
        if (hipOccupancyMaxActiveBlocksPerMultiprocessor(&per_cu, (const void*)mega_fwd, 512, LDS_BYTES) != hipSuccess || per_cu < 1) { fprintf(stderr, "kernel_launch: occupancy query says %d\n", per_cu); }
        (void)hipGetLastError();
        grid = cus;
    }
    if (grid < 0) return;
    if (hipMemsetAsync((char*)d_ws + WS_CTL, 0, CTL_BYTES, stream) != hipSuccess) return;
    Args a{};
    for (int i = 0; i < 24; ++i) a.in[i] = (const float*)d_in[i];
    a.out = (float*)d_out; a.ws = (unsigned char*)d_ws;
    hipLaunchKernelGGL(mega_fwd, dim3(grid), dim3(512), LDS_BYTES, stream, a);
}
```

```cpp
#include <hip/hip_runtime.h>
#include <cstdio>
#include <cstdint>
#include <cmath>

#define LAS __attribute__((address_space(3)))
#define GAS __attribute__((address_space(1)))
typedef unsigned short bf16;
typedef short bf16x8 __attribute__((ext_vector_type(8)));
typedef short s16x4 __attribute__((ext_vector_type(4)));
typedef short v4i16_t __attribute__((ext_vector_type(4)));
typedef float f32x4 __attribute__((ext_vector_type(4)));
typedef float f32x2 __attribute__((ext_vector_type(2)));
typedef float f32x16 __attribute__((ext_vector_type(16)));
typedef unsigned u32x4 __attribute__((ext_vector_type(4)));
typedef unsigned u32x2 __attribute__((ext_vector_type(2)));
typedef __bf16 bf16x2_t __attribute__((ext_vector_type(2)));
typedef GAS unsigned gu32;

constexpr int BATCH = 8, SEQ = 4096, DM = 1024, M = BATCH * SEQ, DFF = 2816, NIN = 6474, DEPTH = 2;
constexpr int ACTP = 2304;
constexpr int NWIN = 3584;
constexpr float EPS = 1e-6f;
constexpr float LOG2E = 1.4426950408889634f;
constexpr float C2 = 0.125f * LOG2E;
constexpr int SL_FQ = 0, SL_SQ = 6, SL_CQ = 12, SL_FK = 16, SL_SK = 22, SL_CK = 28, SL_FV = 32, SL_SV = 38, SL_CV = 44, SL_IQ = 48, SL_IK = 52, SL_MISC = 53;
constexpr int KV_FK = 0, KV_SK = 6, KV_CK = 12, KV_FV = 16, KV_SV = 22, KV_CV = 28, KV_IK = 32, KV_SLOTS = 33, A_IQ = 32;
constexpr int SL_MERGED = 16;

constexpr size_t MiB = 1u << 20;
constexpr size_t WS_CTL = 0, CTL_BYTES = 1 * MiB, CTL_CLEAR = 128 * 1024;
constexpr size_t W_GU = 0, W_D = 11 * MiB, W_IN = 33 * MiB / 2  , W_G = 47 * MiB / 2  , W_BR = 59 * MiB / 2  , W_OUT = 63 * MiB / 2  ,
                 W_GU2 = 67 * MiB / 2  , W_D2 = 89 * MiB / 2  , W_LAYER = 50 * MiB;
constexpr size_t WS_W = 1 * MiB;
constexpr size_t WS_XB = 51 * MiB;
constexpr size_t WS_SSP = 115 * MiB;
constexpr size_t WS_LOGF = 117 * MiB;
constexpr size_t WS_WI = 118 * MiB;
constexpr size_t WS_PAR = 118 * MiB + 512 * 1024;
constexpr size_t WS_POS = 118 * MiB + 576 * 1024;
constexpr size_t WS_MASK = 119 * MiB;
constexpr size_t WS_GATES = 135 * MiB;
constexpr size_t WS_ACT = 231 * MiB;
constexpr size_t WS_KVH = 375 * MiB;
constexpr size_t WS_END = 507 * MiB;
static_assert(WS_ACT + (size_t)M * ACTP * 2 == WS_KVH && WS_KVH + (size_t)KV_SLOTS * M * 128 == WS_END, "ws map");
constexpr int CW_BAR = 4096, CW_Q = 8192, CW_RDY = 16384;
#ifndef PROBE
#define PROBE 0
#endif
#ifndef SELP
#define SELP 0
#endif
#ifndef EPIP
#define EPIP 0
#endif

constexpr int RING_BYTES = 131072;
constexpr int LDS_BYTES = 163840;
constexpr int MISC_OFF = LDS_BYTES - 1024;

__device__ __forceinline__ unsigned cvtpk(float lo, float hi) { f32x2 v = {lo, hi}; bf16x2_t b = __builtin_convertvector(v, bf16x2_t); return __builtin_bit_cast(unsigned, b); }
__device__ __forceinline__ float bf2f(unsigned short h) { return __uint_as_float((unsigned)h << 16); }
__device__ __forceinline__ float bflo(unsigned w) { return __uint_as_float(w << 16); }
__device__ __forceinline__ float bfhi(unsigned w) { return __uint_as_float(w & 0xffff0000u); }
#define VM_WAIT() asm volatile("s_waitcnt vmcnt(0)" ::: "memory")
#ifndef AOFF
#define AOFF 4
#endif
#define ALIGN_LOOP() asm volatile(".p2alignl 6, 0xBF800000\n\t.rept " KSTR(AOFF) "\n\ts_nop 0\n\t.endr")
#ifndef KOFF
#define KOFF 8
#endif
#define ALIGN_LOOP_K() asm volatile(".p2alignl 6, 0xBF800000\n\t.rept " KSTR(KOFF) "\n\ts_nop 0\n\t.endr")
#define KSTR_(x) #x
#define KSTR(x) KSTR_(x)
#define LOCAL_F(name, val) float name = (val); asm volatile("" : "+v"(name))
#define LOCAL_U(name, val) unsigned name = (val); asm volatile("" : "+v"(name))
#define LOCAL_I(name, val) int name = (val); asm volatile("" : "+v"(name))
constexpr int TIDMAP_OFF = 163840 - 1024 + 256;
__device__ __forceinline__ int otid() {
    extern __shared__ __attribute__((aligned(16))) unsigned char lds_raw[];
    const unsigned hw = (unsigned)__builtin_amdgcn_s_getreg((5 << 11) | 4);
    const int w = __builtin_amdgcn_readfirstlane(((volatile LAS int*)((LAS unsigned char*)lds_raw + TIDMAP_OFF))[hw]);
    int lane; asm volatile("v_mbcnt_lo_u32_b32 %0, -1, 0\n\tv_mbcnt_hi_u32_b32 %0, -1, %0" : "=v"(lane));
    return (w << 6) | lane;
}
constexpr int ARGTAB_OFF = 163840 - 1024 + 512;
__device__ __forceinline__ const float* arg_in(int i) {
    extern __shared__ __attribute__((aligned(16))) unsigned char lds_raw[];
    const volatile LAS unsigned* p = (const volatile LAS unsigned*)((LAS unsigned char*)lds_raw + ARGTAB_OFF) + 2 * i;
    const unsigned lo = (unsigned)__builtin_amdgcn_readfirstlane((int)p[0]), hi = (unsigned)__builtin_amdgcn_readfirstlane((int)p[1]);
    return (const float*)(((unsigned long long)hi << 32) | lo);
}
#define RLX_AGENT __ATOMIC_RELAXED, __HIP_MEMORY_SCOPE_AGENT

namespace pg8 {
constexpr int BM = 256, BK = 64, HALF = 128, HTB = HALF * BK * 2, STAGE_BYTES = 8 * HTB, NXCD = 8, WGM = 8;
__device__ __forceinline__ int lds_byte(int r, int c) { const int st = (r >> 4) * 2 + (c >> 5), rr = r & 15, cc = c & 31, ob = rr * 64 + cc * 2; return st * 1024 + (ob ^ (((ob >> 9) & 1) << 5)); }
__device__ __forceinline__ void stage_rc(int b, int& R, int& C) { const int st = b / 1024, sb = b % 1024, swz = sb ^ (((sb >> 9) & 1) << 5); R = (st >> 1) * 16 + swz / 64; C = (st & 1) * 32 + (swz % 64) / 2; }
__device__ __forceinline__ int perm32(int rho) { const int n = rho >> 4, i = rho & 15; return 8 * (i >> 2) + 4 * n + (i & 3); }

struct GUnit { unsigned a, b, lda, ldb; int nt, pm, pn, mode, ui; };

template <int NM, int NN>
struct TileOrder {
    static_assert(NM % WGM == 0 && (NM * NN) % NXCD == 0, "tile order");
    int G, c;
    __device__ void init(int G_, int c_) { G = G_; c = c_; }
    __device__ bool tile(int i, int& pm, int& pn) const {
        constexpr int nwg = NM * NN, q = nwg / NXCD, nig = WGM * NN;
        const unsigned L = (unsigned)i * (unsigned)G + (unsigned)c; if (L >= (unsigned)nwg) return false;
        const unsigned wgid = (L % NXCD) * q + L / NXCD;
        const unsigned gid = wgid / nig, rem = wgid % nig;
        pm = (int)(gid * WGM + rem % WGM); pn = (int)(rem / WGM); return true;
    }
};

template <class Epi, class Sched>
__device__ __forceinline__ void gemm_phase(LAS unsigned char* lds, const unsigned char* wsb, const Sched& S, const Epi& E) {
    int tid = otid();
    const int wid = __builtin_amdgcn_readfirstlane(tid >> 6), lane = tid & 63, wr = wid >> 2, wc = wid & 3, fr = lane & 15, fq = lane >> 4;
    unsigned RA[2], RB[2], CC[2];
#pragma unroll
    for (int i = 0; i < 2; ++i) { int R, C; stage_rc(tid * 16 + i * 8192, R, C); RA[i] = (unsigned)R; RB[i] = (unsigned)((R & ~31) + perm32(R & 31)); CC[i] = (unsigned)(C * 2); }
    const unsigned kstep = BK * 2;
    const unsigned ldsw = (unsigned)wid * 1024u;
    const int aoff = lds_byte(wr * 64 + fr, fq * 8), boff = lds_byte(wc * 32 + fr, fq * 8);
#define PG8_SA(b, h) (((b) * 2 + (h)) * HTB)
#define PG8_SB(b, h) ((4 + (b) * 2 + (h)) * HTB)
#define PG8_STAGE(bufoff, soff, RR, ld) do { _Pragma("unroll") for (int _i = 0; _i < 2; ++_i) { const unsigned _o = (soff) + RR[_i] * (ld) + CC[_i]; \
        __builtin_amdgcn_global_load_lds((const unsigned*)(wsb + _o), (LAS unsigned*)(lds + (bufoff) + ldsw + _i * 8192), 16, 0, 0); } } while (0)
#define PG8_LDA(dst, b, h) do { _Pragma("unroll") for (int m = 0; m < 4; ++m) _Pragma("unroll") for (int k = 0; k < 2; ++k) dst[m][k] = *(const LAS bf16x8*)(lds + PG8_SA(b, h) + aoff + m * 2048 + k * 1024); } while (0)
#define PG8_LDB(dst, b, h) do { _Pragma("unroll") for (int n = 0; n < 2; ++n) _Pragma("unroll") for (int k = 0; k < 2; ++k) dst[n][k] = *(const LAS bf16x8*)(lds + PG8_SB(b, h) + boff + n * 2048 + k * 1024); } while (0)
#define PG8_MMA(ai, bj, At, Bt) do { __builtin_amdgcn_s_setprio(1); _Pragma("unroll") for (int m = 0; m < 4; ++m) _Pragma("unroll") for (int n = 0; n < 2; ++n) _Pragma("unroll") for (int k = 0; k < 2; ++k) \
        acc[ai][bj][m][n] = __builtin_amdgcn_mfma_f32_16x16x32_bf16(Bt[n][k], At[m][k], acc[ai][bj][m][n], 0, 0, 0); __builtin_amdgcn_s_setprio(0); } while (0)
#define PG8_WAIT_V(n) asm volatile("s_waitcnt vmcnt(" #n ")" ::: "memory")
#define PG8_WAIT_L(n) asm volatile("s_waitcnt lgkmcnt(" #n ")" ::: "memory")
#define PG8_BAR __builtin_amdgcn_s_barrier()
#define PG8_SCHED __builtin_amdgcn_sched_barrier(0)
    GUnit cur, nxt; int ui = 0;
    if (!S.get(0, cur)) return;
    f32x4 acc[2][2][4][2];
#pragma unroll
    for (int a = 0; a < 2; ++a)
#pragma unroll
        for (int b = 0; b < 2; ++b)
#pragma unroll
            for (int m = 0; m < 4; ++m)
#pragma unroll
                for (int n = 0; n < 2; ++n) acc[a][b][m][n] = (f32x4){0.f, 0.f, 0.f, 0.f};
    bf16x8 At[4][2], B0[2][2], B1[2][2];
    {
        const unsigned cA = cur.a, cB = cur.b, hA = HALF * cur.lda, hB = HALF * cur.ldb;
        PG8_STAGE(PG8_SB(0, 0), cB, RB, cur.ldb); PG8_STAGE(PG8_SB(0, 1), cB + hB, RB, cur.ldb); PG8_STAGE(PG8_SA(0, 0), cA, RA, cur.lda); PG8_STAGE(PG8_SA(0, 1), cA + hA, RA, cur.lda);
        if (wr == 1) PG8_BAR;
        PG8_WAIT_V(2); PG8_BAR;
        PG8_STAGE(PG8_SB(1, 0), cB + kstep, RB, cur.ldb); PG8_STAGE(PG8_SA(1, 0), cA + kstep, RA, cur.lda); PG8_STAGE(PG8_SB(1, 1), cB + hB + kstep, RB, cur.ldb);
        PG8_WAIT_V(6); PG8_BAR;
    }
    for (;;) {
        const bool has_next = S.get(ui + 1, nxt);
        if (!has_next) { nxt = cur; }
        const unsigned cA = cur.a, cB = cur.b, lda = cur.lda, hA = HALF * cur.lda;
        const int nt = cur.nt;
        for (int t = 0; t < nt; t += 2) {
            const bool last = (t == nt - 2);
            const unsigned a1 = cA + (unsigned)(t + 1) * kstep;
            const unsigned a2 = last ? nxt.a : cA + (unsigned)(t + 2) * kstep, b2 = last ? nxt.b : cB + (unsigned)(t + 2) * kstep;
            const unsigned a3 = a2 + kstep, b3 = b2 + kstep;
            const unsigned lda2 = last ? nxt.lda : cur.lda, ldb2 = last ? nxt.ldb : cur.ldb, hA2 = HALF * lda2, hB2 = HALF * ldb2;
            PG8_LDB(B0, 0, 0); PG8_LDB(B1, 0, 1); PG8_SCHED; PG8_LDA(At, 0, 0); PG8_STAGE(PG8_SA(1, 1), a1 + hA, RA, lda);
            PG8_WAIT_V(8); PG8_WAIT_L(0); PG8_BAR; PG8_MMA(0, 0, At, B0); PG8_MMA(0, 1, At, B1); PG8_BAR; PG8_SCHED;
            PG8_LDA(At, 0, 1); PG8_STAGE(PG8_SB(0, 0), b2, RB, ldb2); PG8_STAGE(PG8_SB(0, 1), b2 + hB2, RB, ldb2); PG8_STAGE(PG8_SA(0, 0), a2, RA, lda2);
            PG8_WAIT_V(8); PG8_WAIT_L(0); PG8_BAR; PG8_MMA(1, 0, At, B0); PG8_MMA(1, 1, At, B1); PG8_BAR; PG8_SCHED;
            PG8_LDB(B0, 1, 0); PG8_LDB(B1, 1, 1); PG8_SCHED; PG8_LDA(At, 1, 0); PG8_STAGE(PG8_SA(0, 1), a2 + hA2, RA, lda2);
            PG8_WAIT_V(8); PG8_WAIT_L(0); PG8_BAR; PG8_MMA(0, 0, At, B0); PG8_MMA(0, 1, At, B1); PG8_BAR; PG8_SCHED;
            PG8_LDA(At, 1, 1); PG8_STAGE(PG8_SB(1, 0), b3, RB, ldb2); PG8_STAGE(PG8_SB(1, 1), b3 + hB2, RB, ldb2); PG8_STAGE(PG8_SA(1, 0), a3, RA, lda2);
            PG8_WAIT_V(8); PG8_WAIT_L(0); PG8_BAR; PG8_MMA(1, 0, At, B0); PG8_MMA(1, 1, At, B1); PG8_BAR; PG8_SCHED;
        }
        if (wr == 0) PG8_BAR;
        asm volatile("" ::: "memory"); PG8_SCHED;
        { int fr_ = fr, fq_ = fq, tid_ = tid; asm volatile("" : "+v"(fr_), "+v"(fq_), "+v"(tid_));
          E(acc, cur, wr, wc, fr_, fq_, tid_);
          if (EPIP && Epi::twice) { asm volatile("" : "+v"(fr_), "+v"(fq_), "+v"(tid_)); E(acc, cur, wr, wc, fr_, fq_, tid_); } }
        asm volatile("" ::: "memory"); PG8_SCHED;
        if (!has_next) break;
        if (!Epi::keep(cur.mode)) {
#pragma unroll
            for (int a = 0; a < 2; ++a)
#pragma unroll
                for (int b = 0; b < 2; ++b)
#pragma unroll
                    for (int m = 0; m < 4; ++m)
#pragma unroll
                        for (int n = 0; n < 2; ++n) {
                            unsigned long long z0, z1; asm volatile("v_mov_b64 %0, 0\n\tv_mov_b64 %1, 0" : "=v"(z0), "=v"(z1));
                            acc[a][b][m][n] = (f32x4){__uint_as_float((unsigned)z0), __uint_as_float((unsigned)(z0 >> 32)), __uint_as_float((unsigned)z1), __uint_as_float((unsigned)(z1 >> 32))}; }
        }
        cur = nxt;
        ++ui;
        if (wr == 1) PG8_BAR;
    }
    PG8_WAIT_V(0);
    PG8_BAR;
#undef PG8_SA
#undef PG8_SB
#undef PG8_STAGE
#undef PG8_LDA
#undef PG8_LDB
#undef PG8_MMA
#undef PG8_WAIT_V
#undef PG8_WAIT_L
#undef PG8_BAR
#undef PG8_SCHED
}

typedef f32x4 Acc[2][2][4][2];
__device__ __forceinline__ float quad_sum(float v) {
    const unsigned a = __float_as_uint(v);
    auto r = __builtin_amdgcn_permlane16_swap(a, a, false, false);
    const float t = __uint_as_float(r[0]) + __uint_as_float(r[1]);
    const unsigned b = __float_as_uint(t);
    auto q = __builtin_amdgcn_permlane32_swap(b, b, false, false);
    return __uint_as_float(q[0]) + __uint_as_float(q[1]);
}
template <bool MSQ>
__device__ __forceinline__ void row_rstd_(float (&rs)[2][4], float (&msq)[2][4], const float* ssp, int row0, int fq) {
#pragma unroll
    for (int ai = 0; ai < 2; ++ai)
#pragma unroll
        for (int m = 0; m < 4; ++m) {
            const f32x4 p = *(const f32x4*)(ssp + (size_t)(row0 + ai * HALF + m * 16) * 16 + 4 * fq);
            float s = (p[0] + p[1]) + (p[2] + p[3]);
            s = quad_sum(s);
            const float q = (s + EPS * DM) * (1.0f / DM);
            rs[ai][m] = __builtin_amdgcn_rsqf(q);
            if (MSQ) msq[ai][m] = q;
        }
}
__device__ __forceinline__ void row_rstd(float (&rs)[2][4], const float* ssp, int row0, int fq) {
#pragma unroll
    for (int ai = 0; ai < 2; ++ai)
#pragma unroll
        for (int m = 0; m < 4; ++m) {
            const f32x4 p = *(const f32x4*)(ssp + (size_t)(row0 + ai * HALF + m * 16) * 16 + 4 * fq);
            float s = (p[0] + p[1]) + (p[2] + p[3]);
            s = quad_sum(s);
            rs[ai][m] = __builtin_amdgcn_rsqf((s + EPS * DM) * (1.0f / DM));
        }
}
constexpr int RQ_OFF = 131072;
template <class Sched>
__device__ __forceinline__ void rowq_table(LAS unsigned char* lds, const unsigned char* ws, const Sched& S) {
    const int tid = otid();
    const float* ssp = (const float*)(ws + WS_SSP);
    LAS float* tab = (LAS float*)(lds + RQ_OFF);
    for (int e0 = tid; ; e0 += 2048) {
        f32x4 p4[4][4]; bool ok[4];
#pragma unroll
        for (int r = 0; r < 4; ++r) { const int e = e0 + 512 * r; GUnit u; ok[r] = S.get(e >> 8, u);
            if (ok[r]) { const float* p = ssp + (size_t)(u.pm * BM + (e & 255)) * 16;
                p4[r][0] = *(const f32x4*)p; p4[r][1] = *(const f32x4*)(p + 4); p4[r][2] = *(const f32x4*)(p + 8); p4[r][3] = *(const f32x4*)(p + 12); } }
#pragma unroll
        for (int r = 0; r < 4; ++r) if (ok[r]) { const f32x4 a = p4[r][0], b = p4[r][1], c = p4[r][2], d = p4[r][3];
            const float sm = (((a[0] + a[1]) + (a[2] + a[3])) + ((b[0] + b[1]) + (b[2] + b[3]))) + (((c[0] + c[1]) + (c[2] + c[3])) + ((d[0] + d[1]) + (d[2] + d[3])));
            tab[e0 + 512 * r] = (sm + EPS * DM) * (1.0f / DM); }
        if (!ok[3]) break;
    }
    __syncthreads();
}
template <bool MSQ>
__device__ __forceinline__ void row_rstd_lds(float (&rs)[2][4], float (&msq)[2][4], int ui, int wr, int fr) {
    extern __shared__ __attribute__((aligned(16))) unsigned char lds_raw[];
    const LAS float* t = (const LAS float*)((LAS unsigned char*)lds_raw + RQ_OFF) + ui * 256 + wr * 64 + fr;
#pragma unroll
    for (int ai = 0; ai < 2; ++ai)
#pragma unroll
        for (int m = 0; m < 4; ++m) { const float q = t[ai * HALF + m * 16]; rs[ai][m] = __builtin_amdgcn_rsqf(q); if (MSQ) msq[ai][m] = q; }
}
__device__ __forceinline__ float sigmoidf_(float x) { return __builtin_amdgcn_rcpf(1.0f + __builtin_amdgcn_exp2f(-x * LOG2E)); }

struct EpiUp {
    static constexpr bool twice = true;
    unsigned char* ws;
    static __device__ __forceinline__ bool keep(int) { return false; }
    __device__ __forceinline__ void operator()(Acc& acc, const GUnit& u, int wr, int wc, int fr, int fq, int tid) const {
        bf16* H = (bf16*)(ws + WS_ACT); const float* ssp = (const float*)(ws + WS_SSP);
        const int row0 = u.pm * BM + wr * 64 + fr;
        float rs[2][4], msq[2][4]; row_rstd_lds<true>(rs, msq, u.ui, wr, fr);
        const int col0 = u.pn * HALF + wc * 32 + 8 * fq;
#pragma unroll
        for (int ai = 0; ai < 2; ++ai)
#pragma unroll
            for (int m = 0; m < 4; ++m) {
                const float rneg = -rs[ai][m] * LOG2E, q = msq[ai][m]; float h[8];
#pragma unroll
                for (int n = 0; n < 2; ++n)
#pragma unroll
                    for (int e = 0; e < 4; ++e) { const float g = acc[ai][0][m][n][e], up = acc[ai][1][m][n][e];
                        const float ex = __builtin_amdgcn_exp2f(g * rneg); h[4 * n + e] = (g * up) * __builtin_amdgcn_rcpf(__builtin_fmaf(ex, q, q)); }
                u32x4 w; w.x = cvtpk(h[0], h[1]); w.y = cvtpk(h[2], h[3]); w.z = cvtpk(h[4], h[5]); w.w = cvtpk(h[6], h[7]);
                *(u32x4*)(H + (size_t)(row0 + ai * HALF + m * 16) * DFF + col0) = w;
                asm volatile("" ::: "memory");
            }
    }
};
struct EpiRes {
    static constexpr bool twice = false;
    unsigned char* ws; float* outf; float alpha;
    static __device__ __forceinline__ bool keep(int) { return false; }
    __device__ __forceinline__ void operator()(Acc& acc, const GUnit& u, int wr, int wc, int fr, int fq, int tid) const {
        bf16* xb = (bf16*)(ws + WS_XB); float* ssp = (float*)(ws + WS_SSP);
        const int row0 = u.pm * BM + wr * 64 + fr, col0 = u.pn * BM + wc * 32 + 8 * fq;
#pragma unroll
        for (int ai = 0; ai < 2; ++ai) {
        u32x4 bv[4][2];
#pragma unroll
            for (int m = 0; m < 4; ++m)
#pragma unroll
                for (int bj = 0; bj < 2; ++bj) bv[m][bj] = *(const u32x4*)(xb + (size_t)(row0 + ai * HALF + m * 16) * DM + col0 + bj * HALF);
#pragma unroll
            for (int m = 0; m < 4; ++m) {
                const int row = row0 + ai * HALF + m * 16; float ssq = 0.f;
#pragma unroll
                for (int bj = 0; bj < 2; ++bj) {
                    const size_t off = (size_t)row * DM + col0 + bj * HALF;
                    const u32x4 b = bv[m][bj];
                    const f32x4 v0 = (f32x4){bflo(b.x), bfhi(b.x), bflo(b.y), bfhi(b.y)} + alpha * acc[ai][bj][m][0];
                    const f32x4 v1 = (f32x4){bflo(b.z), bfhi(b.z), bflo(b.w), bfhi(b.w)} + alpha * acc[ai][bj][m][1];
                    if (outf) { *(f32x4*)(outf + off) = v0; *(f32x4*)(outf + off + 4) = v1; }
                    else {
                        u32x4 w; w.x = cvtpk(v0[0], v0[1]); w.y = cvtpk(v0[2], v0[3]); w.z = cvtpk(v1[0], v1[1]); w.w = cvtpk(v1[2], v1[3]);
                        *(u32x4*)(xb + off) = w;
                        const float r0 = bflo(w.x), r1 = bfhi(w.x), r2 = bflo(w.y), r3 = bfhi(w.y), r4 = bflo(w.z), r5 = bfhi(w.z), r6 = bflo(w.w), r7 = bfhi(w.w);
                        ssq += (r0 * r0 + r1 * r1) + (r2 * r2 + r3 * r3) + (r4 * r4 + r5 * r5) + (r6 * r6 + r7 * r7);
                    }
                }
                if (!outf) {
                    ssq = quad_sum(ssq);
                    if (fq == 0) ssp[(size_t)row * 16 + 4 * u.pn + wc] = ssq;
                }
            }
            asm volatile("" ::: "memory");
        }
    }
};
struct EpiWin {
    static constexpr bool twice = false;
    unsigned char* ws; int l;
    static __device__ __forceinline__ bool keep(int) { return false; }
    __device__ __forceinline__ void operator()(Acc& acc, const GUnit& u, int wr, int wc, int fr, int fq, int tid) const {
        const int slot = 4 * u.pn + wc;
        if (slot >= 54 && u.pn < 14) return;
        bf16* act = (bf16*)(ws + WS_ACT); const float* ssp = (const float*)(ws + WS_SSP); const float* par = (const float*)(ws + WS_PAR) + l * 4096;
        const int row0 = u.pm * BM + wr * 64 + fr;
        float rs[2][4], msq_[2][4]; row_rstd_lds<false>(rs, msq_, u.ui, wr, fr);
        if (u.pn >= 14) {
            const int x = (u.pn - 14) >> 2, col0 = ((u.pn - 14) & 3) * BM + wc * 32 + 8 * fq;
            const float* bgate = par + 512 + x * DM;
            LOCAL_F(k255, 1.0f / 255.0f);
            unsigned char* gdst = ws + WS_GATES + (size_t)((x * (M / BM) + u.pm) * 4 + ((u.pn - 14) & 3)) * 65536 + (wr * 4 + wc) * 8192 + (fq * 16 + fr) * 8 + 4096;
#pragma unroll
            for (int bj = 0; bj < 2; ++bj) {
                const f32x4 bv0 = *(const f32x4*)(bgate + col0 + bj * HALF) * (-LOG2E), bv1 = *(const f32x4*)(bgate + col0 + bj * HALF + 4) * (-LOG2E);
#pragma unroll
                for (int ai = 0; ai < 2; ++ai)
#pragma unroll
                    for (int m = 0; m < 4; ++m) {
                        u32x2 w; w.x = 0u; w.y = 0u;
                        const float rneg = -rs[ai][m] * LOG2E;
#pragma unroll
                        for (int j = 0; j < 4; ++j) {
                            w.x = __builtin_amdgcn_cvt_pk_u8_f32(__builtin_amdgcn_rcpf(__builtin_fmaf(__builtin_amdgcn_exp2f(__builtin_fmaf(acc[ai][bj][m][0][j], rneg, bv0[j])), k255, k255)), j, w.x);
                            w.y = __builtin_amdgcn_cvt_pk_u8_f32(__builtin_amdgcn_rcpf(__builtin_fmaf(__builtin_amdgcn_exp2f(__builtin_fmaf(acc[ai][bj][m][1][j], rneg, bv1[j])), k255, k255)), j, w.y); }
                        *(u32x2*)(gdst + (((ai * 4 + m) * 2 + bj) * 512 - 4096)) = w;
                    }
            }
            return;
        }
        const bool rope = (slot >= SL_CQ && slot < SL_FK) || (slot >= SL_CK && slot < SL_FV) || (slot >= SL_IQ && slot <= SL_IK);
        if (slot == SL_MISC) {
            float* logf = (float*)(ws + WS_LOGF); float* wi = (float*)(ws + WS_WI);
#pragma unroll
            for (int ai = 0; ai < 2; ++ai)
#pragma unroll
                for (int m = 0; m < 4; ++m) {
                    const int row = row0 + ai * HALF + m * 16; const float r = rs[ai][m];
                    if (fq == 0) {
                        const int b = row >> 12, s = row & (SEQ - 1);
#pragma unroll
                        for (int j = 0; j < 6; ++j) { const float z = acc[ai][0][m][j >> 2][j & 3] * r + par[384 + j];
                            const float lf = fminf(z, 0.f) - 0.6931471805599453f * __builtin_amdgcn_logf(1.0f + __builtin_amdgcn_exp2f(-fabsf(z) * LOG2E));
                            logf[((size_t)b * 6 + j) * SEQ + s] = lf; }
                    } else if (fq == 1) {
                        f32x4 w = acc[ai][0][m][0] * (r * 0.5f * 0.125f);
                        *(f32x4*)(wi + (size_t)row * 4) = w;
                    }
                }
            return;
        }
        const bool norm = slot < SL_FV;
        const int gidx = slot < SL_SQ ? 0 : slot < SL_CQ ? 2 : slot < SL_FK ? 4 : slot < SL_SK ? 1 : slot < SL_CK ? 3 : 5;
        const float* gp = par + 64 * gidx;
        LOCAL_F(kC2, C2);
        const float qs = slot < SL_FK ? kC2 : 1.0f;
        int lb0 = 8 * fq, lb1 = 32 + 8 * fq;
        if (rope) { if (fq == 1) lb0 = 32; if (fq == 0) lb1 = 8; }
        f32x4 g[2][2];
        g[0][0] = *(const f32x4*)(gp + lb0); g[0][1] = *(const f32x4*)(gp + lb0 + 4); g[1][0] = *(const f32x4*)(gp + lb1); g[1][1] = *(const f32x4*)(gp + lb1 + 4);
        const int* pos = (const int*)(ws + WS_POS);
        int posv[2][4];
#pragma unroll
        for (int ai = 0; ai < 2; ++ai)
#pragma unroll
            for (int m = 0; m < 4; ++m) posv[ai][m] = pos[row0 + ai * HALF + m * 16];
        bf16* dst; int dstride;
        if (slot < SL_FK) { dst = act + (size_t)slot * 64 + 8 * fq; dstride = ACTP; }
        else if (slot < SL_IQ) { dst = (bf16*)(ws + WS_KVH) + (size_t)(slot - 16) * M * 64 + 8 * fq; dstride = 64; }
        else if (slot < SL_IK) { dst = act + (size_t)(A_IQ + slot - SL_IQ) * 64 + 8 * fq; dstride = ACTP; }
        else { dst = (bf16*)(ws + WS_KVH) + (size_t)KV_IK * M * 64 + 8 * fq; dstride = 64; }
#pragma unroll
        for (int ai = 0; ai < 2; ++ai)
#pragma unroll
            for (int m = 0; m < 4; ++m) {
                const int row = row0 + ai * HALF + m * 16; const float r = rs[ai][m];
                f32x4 z[2][2];
#pragma unroll
                for (int bj = 0; bj < 2; ++bj)
#pragma unroll
                    for (int n = 0; n < 2; ++n) z[bj][n] = acc[ai][bj][m][n] * r;
                if (norm) {
                    float ss = 0.f;
#pragma unroll
                    for (int bj = 0; bj < 2; ++bj)
#pragma unroll
                        for (int n = 0; n < 2; ++n) ss += (z[bj][n][0] * z[bj][n][0] + z[bj][n][1] * z[bj][n][1]) + (z[bj][n][2] * z[bj][n][2] + z[bj][n][3] * z[bj][n][3]);
                    ss = quad_sum(ss);
                    const float hn = qs * __builtin_amdgcn_rsqf((ss + EPS * 64.0f) * (1.0f / 64.0f));
#pragma unroll
                    for (int bj = 0; bj < 2; ++bj)
#pragma unroll
                        for (int n = 0; n < 2; ++n) z[bj][n] = z[bj][n] * (g[bj][n] * hn);
                }
                if (rope && fq == 0) {
                    const float pf = (float)posv[ai][m];
                    const float invf[8] = {1.0f, 0.19393070f, 0.037609117f, 0.0072935625f, 0.0014144452f, 0.00027430436f, 5.3196042e-05f, 1.0316346e-05f};
#pragma unroll
                    for (int j = 0; j < 8; ++j) {
                        const float ang = pf * invf[j]; float rev = ang * 0.15915494309189535f; rev = rev - floorf(rev);
                        const float sn = __builtin_amdgcn_sinf(rev), cs = __builtin_amdgcn_cosf(rev);
                        const float x1 = z[0][j >> 2][j & 3], x2 = z[1][j >> 2][j & 3];
                        z[0][j >> 2][j & 3] = x1 * cs - x2 * sn; z[1][j >> 2][j & 3] = x2 * cs + x1 * sn;
                    }
                }
#pragma unroll
                for (int bj = 0; bj < 2; ++bj) {
                    u32x4 w; w.x = cvtpk(z[bj][0][0], z[bj][0][1]); w.y = cvtpk(z[bj][0][2], z[bj][0][3]); w.z = cvtpk(z[bj][1][0], z[bj][1][1]); w.w = cvtpk(z[bj][1][2], z[bj][1][3]);
                    *(u32x4*)(dst + (size_t)row * dstride + 32 * bj) = w;
                }
                asm volatile("" ::: "memory");
            }
    }
};
struct EpiMerge {
    static constexpr bool twice = false;
    unsigned char* ws;
    static __device__ __forceinline__ bool keep(int mode) { return mode < 2; }
    __device__ __forceinline__ void operator()(Acc& acc, const GUnit& u, int wr, int wc, int fr, int fq, int tid) const {
        const int x = u.mode;
        LOCAL_F(k255, 1.0f / 255.0f);
        const int row0 = u.pm * BM + wr * 64 + fr, col0 = u.pn * BM + wc * 32 + 8 * fq;
        const size_t goff = (size_t)(u.pm * 4 + u.pn) * 65536 + (wr * 4 + wc) * 8192 + (fq * 16 + fr) * 8 + 4096;
        const unsigned char* ga_p = ws + WS_GATES + (size_t)x * (M / BM) * 4 * 65536 + goff;
        const unsigned char* gb_p = ws + WS_GATES + (size_t)(x < 2 ? x + 1 : x) * (M / BM) * 4 * 65536 + goff;
        bf16* merged = (bf16*)(ws + WS_ACT) + SL_MERGED * 64;
        u32x2 gav[2][4][2], gbv[2][4][2];
#pragma unroll
        for (int ai = 0; ai < 2; ++ai)
#pragma unroll
            for (int m = 0; m < 4; ++m)
#pragma unroll
                for (int bj = 0; bj < 2; ++bj) { const int go = ((ai * 4 + m) * 2 + bj) * 512 - 4096; gav[ai][m][bj] = *(const u32x2*)(ga_p + go); gbv[ai][m][bj] = *(const u32x2*)(gb_p + go); }
#pragma unroll
        for (int ai = 0; ai < 2; ++ai)
#pragma unroll
            for (int m = 0; m < 4; ++m) {
                const size_t ro = (size_t)(row0 + ai * HALF + m * 16);
#pragma unroll
                for (int bj = 0; bj < 2; ++bj) {
                    const u32x2 ga = gav[ai][m][bj], gb = gbv[ai][m][bj];
                    float o[8];
#pragma unroll
                    for (int j = 0; j < 8; ++j) {
                        const float fa = (float)(((j < 4 ? ga.x : ga.y) >> (8 * (j & 3))) & 255u), fb = (float)(((j < 4 ? gb.x : gb.y) >> (8 * (j & 3))) & 255u);
                        const float fa2 = x == 0 ? fa : fmaxf(fa, 0.5f);
                        const float f = (x < 2) ? fa2 * __builtin_amdgcn_rcpf(fmaxf(fb, 0.5f)) : fa2 * k255;
                        o[j] = acc[ai][bj][m][j >> 2][j & 3] * f; acc[ai][bj][m][j >> 2][j & 3] = o[j];
                    }
                    if (x == 2) { u32x4 w; w.x = cvtpk(o[0], o[1]); w.y = cvtpk(o[2], o[3]); w.z = cvtpk(o[4], o[5]); w.w = cvtpk(o[6], o[7]);
                        *(u32x4*)(merged + ro * ACTP + col0 + bj * HALF) = w; }
                }
            }
    }
};
}

namespace att {
constexpr int NW = 8, QBLK = 32, QB = 256, KVBLK = 64, SLOTB = 8192;
constexpr int LDS_K = 0, LDS_V = 2 * SLOTB, LDS_WS = 4 * SLOTB, LDS_OST = LDS_WS + NW * 256, LDS_F = LDS_OST + NW * 4096, LDS_END = LDS_F + 4096 * 4 + 64 + 64;
static_assert(LDS_END <= RING_BYTES, "attention LDS");
typedef const LAS char* lptr;
__device__ __forceinline__ int crow(int r, int hi) { return (r & 3) + 8 * (r >> 2) + 4 * hi; }
__device__ __forceinline__ void glds16(const void* gsrc, unsigned lds_dst) { unsigned keep;
    asm volatile("s_mov_b32 %0, m0\n\ts_mov_b32 m0, %2\n\ts_nop 0\n\tglobal_load_lds_dwordx4 %1, off\n\ts_mov_b32 m0, %0" : "=&s"(keep) : "v"(gsrc), "s"(lds_dst) : "memory"); }
#define ATT_WAIT_BAR() asm volatile("s_waitcnt vmcnt(0) lgkmcnt(0)\n\ts_barrier" ::: "memory")
#define MFMA32(a, b, c) __builtin_amdgcn_mfma_f32_32x32x16_bf16(a, b, c, 0, 0, 0)
__device__ __forceinline__ void qkt(f32x16& p0, f32x16& p1, lptr kslot, const bf16x8* qr, int r32, int hi) {
    lptr kb = kslot + hi * 1024 + r32 * 16;
    f32x16 z = {};
    p0 = z; p1 = z;
#pragma unroll
    for (int d0 = 0; d0 < 4; ++d0) {
        const bf16x8 b0 = *(const LAS bf16x8*)(kb + d0 * 2048);
        const bf16x8 b1 = *(const LAS bf16x8*)(kb + d0 * 2048 + 512);
        p0 = MFMA32(b0, qr[d0], p0); p1 = MFMA32(b1, qr[d0], p1);
    }
}
__device__ __forceinline__ s16x4 vtr(lptr p) { return __builtin_bit_cast(s16x4, __builtin_amdgcn_ds_read_tr16_b64_v4i16((LAS v4i16_t*)p)); }
__device__ __forceinline__ void pv(f32x16* o, lptr vp, const f32x16& p0, const f32x16& p1) {
    u32x4 pw[4];
    pw[0] = (u32x4){cvtpk(p0[0], p0[1]), cvtpk(p0[2], p0[3]), cvtpk(p0[4], p0[5]), cvtpk(p0[6], p0[7])};
    pw[1] = (u32x4){cvtpk(p0[8], p0[9]), cvtpk(p0[10], p0[11]), cvtpk(p0[12], p0[13]), cvtpk(p0[14], p0[15])};
    pw[2] = (u32x4){cvtpk(p1[0], p1[1]), cvtpk(p1[2], p1[3]), cvtpk(p1[4], p1[5]), cvtpk(p1[6], p1[7])};
    pw[3] = (u32x4){cvtpk(p1[8], p1[9]), cvtpk(p1[10], p1[11]), cvtpk(p1[12], p1[13]), cvtpk(p1[14], p1[15])};
#pragma unroll
    for (int d0 = 0; d0 < 2; ++d0)
#pragma unroll
        for (int ks = 0; ks < 4; ++ks) {
            const s16x4 lo = vtr(vp + d0 * 4096 + ks * 1024), hi = vtr(vp + d0 * 4096 + ks * 1024 + 512);
            const bf16x8 vf = (bf16x8){lo[0], lo[1], lo[2], lo[3], hi[0], hi[1], hi[2], hi[3]};
            o[d0] = MFMA32(__builtin_bit_cast(bf16x8, pw[ks]), vf, o[d0]);
        }
}
__device__ __forceinline__ float rowmax(const f32x16& p0, const f32x16& p1) {
    float a = fmaxf(p0[0], p1[0]);
#pragma unroll
    for (int r = 1; r < 16; ++r) a = fmaxf(a, fmaxf(p0[r], p1[r]));
    auto rr = __builtin_amdgcn_permlane32_swap(__float_as_uint(a), __float_as_uint(a), false, false);
    return fmaxf(__uint_as_float(rr[0]), __uint_as_float(rr[1]));
}
__device__ __forceinline__ float partner(float v) {
    const unsigned me = __float_as_uint(v);
    auto rr = __builtin_amdgcn_permlane32_swap(me, me, false, false);
    return __uint_as_float(rr[0] == me ? rr[1] : rr[0]);
}

enum { A_FOX = 0, A_SB = 1, A_DSA = 2 };
template <int MODE>
__device__ __forceinline__ void attn_unit(int b, int sq, int sk, int sv, int so, int qb, bf16* ACT, const bf16* KVH, const float* logf_bh, const unsigned* maskw, float smax, LAS char* shm, gu32* qctr, volatile LAS unsigned* nslot) {
    int tid = otid();
    const int lane = tid & 63, r32 = lane & 31, hi = lane >> 5; const int wid = __builtin_amdgcn_readfirstlane(tid >> 6);
    const long rowbase = (long)b * SEQ; const int q0 = qb * QB;
    const bf16* Qw = ACT + (rowbase + q0 + wid * QBLK) * ACTP + sq * 64;
    const bf16* Kh = KVH + ((size_t)sk * M + rowbase) * 64; const bf16* Vh = KVH + ((size_t)sv * M + rowbase) * 64;
    const unsigned lds0 = (unsigned)(uintptr_t)shm;
    LAS float* wsf = (LAS float*)(shm + LDS_WS) + wid * 64;
    LAS float* F2 = (LAS float*)(shm + LDS_F);
    LAS unsigned* sbflag = (LAS unsigned*)(shm + LDS_F);
    LAS unsigned* exflag = (LAS unsigned*)(shm + LDS_F + 4096 * 4 + 64);
    const bf16* ksrc = Kh + (long)lane * 64 + wid * 8;
    const bf16* vsrc = Vh + (long)(16 * (wid & 3) + (lane >> 2)) * 64 + (wid >> 2) * 32 + (lane & 3) * 8;
    const unsigned kdst = lds0 + LDS_K + wid * 1024, vdst = lds0 + LDS_V + wid * 1024;
#define DMA_K(t, slot) glds16(ksrc + (long)(t) * KVBLK * 64, (unsigned)__builtin_amdgcn_readfirstlane(kdst + (slot)))
#define DMA_V(t, slot) glds16(vsrc + (long)(t) * KVBLK * 64, (unsigned)__builtin_amdgcn_readfirstlane(vdst + (slot)))
    lptr kbase = (lptr)shm + LDS_K;
    lptr vp0 = (lptr)shm + LDS_V + ((lane >> 4) & 1) * 32 + (lane & 3) * 8 + (4 * hi + ((lane & 15) >> 2)) * 64;
    const int NT = (q0 + QB) / KVBLK;
#define TILE_AT(i) ((MODE != A_DSA) ? NT - 1 - (i) : (i))
    DMA_K(TILE_AT(0), 0); DMA_V(TILE_AT(0), 0); DMA_K(TILE_AT(1), SLOTB);
    bf16x8 qr[4];
#pragma unroll
    for (int d0 = 0; d0 < 4; ++d0) qr[d0] = *reinterpret_cast<const bf16x8*>(&Qw[(long)r32 * ACTP + d0 * 16 + hi * 8]);
    const int qrel = wid * QBLK + r32, qabs = q0 + qrel;
    float Fq = 0.f;
    if (MODE == A_FOX) {
        const int n = q0 + QB;
        float v[8]; float run = 0.f;
        if (8 * tid < n) { const f32x4 a = *(const f32x4*)(logf_bh + 8 * tid), c = *(const f32x4*)(logf_bh + 8 * tid + 4);
            v[0] = a[0]; v[1] = a[1]; v[2] = a[2]; v[3] = a[3]; v[4] = c[0]; v[5] = c[1]; v[6] = c[2]; v[7] = c[3]; }
        else {
#pragma unroll
            for (int j = 0; j < 8; ++j) v[j] = 0.f; }
#pragma unroll
        for (int j = 0; j < 8; ++j) { run += v[j]; v[j] = run; }
        float inc = run;
#pragma unroll
        for (int o = 1; o < 64; o <<= 1) { const float t = __int_as_float(__builtin_amdgcn_ds_bpermute(((lane >= o ? lane - o : lane)) << 2, __float_as_int(inc))); if (lane >= o) inc += t; }
        LAS float* wtot = (LAS float*)(shm + LDS_F + 4096 * 4);
        if (lane == 63) wtot[wid] = inc;
        __syncthreads();
        float base = inc - run;
        for (int w = 0; w < wid; ++w) base += wtot[w];
        if (8 * tid < n) {
            *(LAS f32x4*)(F2 + 8 * tid) = (f32x4){(base + v[0]) * LOG2E, (base + v[1]) * LOG2E, (base + v[2]) * LOG2E, (base + v[3]) * LOG2E};
            *(LAS f32x4*)(F2 + 8 * tid + 4) = (f32x4){(base + v[4]) * LOG2E, (base + v[5]) * LOG2E, (base + v[6]) * LOG2E, (base + v[7]) * LOG2E};
        }
        __syncthreads();
        Fq = F2[qabs];
    }
    LOCAL_F(NEGINF, -INFINITY);
    float mrun = NEGINF, lsum = 0.f, cq = 1.0f;
    bool wdead = false;
    const int qlast_w = q0 + wid * QBLK + QBLK - 1;
    f32x16 o[2]; o[0] = f32x16{}; o[1] = f32x16{};
    f32x16 pA0, pA1, pB0, pB1;
    unsigned mwA = 0u, mwB = 0u;
    ATT_WAIT_BAR();
    qkt(pA0, pA1, kbase, qr, r32, hi);
    if (MODE == A_DSA) mwA = maskw[((size_t)TILE_AT(0) * SEQ + qabs) * 2 + hi];
    ATT_WAIT_BAR();
    bool stop = false;
#define ATT_STEP(C0, C1, N0, N1, MWC, MWN, IT) do { \
        const int it = (IT); const int t = TILE_AT(it); \
        const int slot = (it & 1) * SLOTB; \
        if (it + 2 < NT) DMA_K(TILE_AT(it + 2), slot); \
        if (it + 1 < NT) { DMA_V(TILE_AT(it + 1), SLOTB - slot); \
            if (!(MODE == A_SB && wdead)) qkt(N0, N1, kbase + (SLOTB - slot), qr, r32, hi); \
            if (MODE == A_DSA) MWN = maskw[((size_t)TILE_AT(it + 1) * SEQ + qabs) * 2 + hi]; } \
        const int kv0 = t * KVBLK; \
        const bool band = (kv0 + KVBLK - 1 >= qlast_w - (QBLK - 1));        \
        bool skp_ = false; \
        if (MODE == A_FOX || MODE == A_DSA) { \
            if (MODE == A_FOX) { \
                _Pragma("unroll") for (int g = 0; g < 4; ++g) { \
                    const f32x4 f0 = *(const LAS f32x4*)(F2 + kv0 + 8 * g + 4 * hi), f1 = *(const LAS f32x4*)(F2 + kv0 + 32 + 8 * g + 4 * hi); \
                    _Pragma("unroll") for (int e = 0; e < 4; ++e) { C0[4 * g + e] += Fq - f0[e]; C1[4 * g + e] += Fq - f1[e]; } \
                } \
            } \
            if (MODE == A_DSA) { \
                _Pragma("unroll") for (int r = 0; r < 16; ++r) { if (!__builtin_amdgcn_ubfe(MWC, r, 1)) C0[r] = NEGINF; if (!__builtin_amdgcn_ubfe(MWC, 16 + r, 1)) C1[r] = NEGINF; } \
            } \
            if (band) { \
                _Pragma("unroll") for (int r = 0; r < 16; ++r) { const int kv = kv0 + crow(r, hi); if (kv > qabs) C0[r] = NEGINF; if (kv + 32 > qabs) C1[r] = NEGINF; } \
            } \
            const float rm = rowmax(C0, C1); \
            const float mnew = fmaxf(mrun, rm); \
            const float msafe = (mnew == NEGINF) ? 0.f : mnew; \
            const float alpha = __builtin_amdgcn_exp2f(mrun - msafe); \
            float ssum = 0.f; \
            _Pragma("unroll") for (int r = 0; r < 16; ++r) { C0[r] = __builtin_amdgcn_exp2f(C0[r] - msafe); C1[r] = __builtin_amdgcn_exp2f(C1[r] - msafe); ssum += C0[r] + C1[r]; } \
            lsum = lsum * alpha + ssum; \
            mrun = mnew; \
            if (__any(alpha != 1.0f)) { \
                if (hi == 0) wsf[r32] = alpha; \
                _Pragma("unroll") for (int r = 0; r < 16; ++r) { const float f = wsf[crow(r, hi)]; o[0][r] *= f; o[1][r] *= f; } \
            } \
        } else if (wdead || kv0 >= qlast_w) {        \
            skp_ = true; \
        } else {     \
            float rr0[16], rr1[16]; \
            _Pragma("unroll") for (int r = 0; r < 16; ++r) { \
                const float e0 = __builtin_amdgcn_exp2f(C0[r]), e1 = __builtin_amdgcn_exp2f(C1[r]);        \
                float q0_ = __builtin_amdgcn_rcpf(1.0f + e0), q1_ = __builtin_amdgcn_rcpf(1.0f + e1); \
                if (band) { const int kv = kv0 + crow(r, hi); if (kv >= qabs) q0_ = 1.f; if (kv + 32 >= qabs) q1_ = 1.f; }        \
                rr0[r] = q0_; rr1[r] = q1_; \
            } \
              \
            float G[8], Gp[8], T[8]; \
            _Pragma("unroll") for (int g = 0; g < 4; ++g) { G[g] = (rr0[4 * g] * rr0[4 * g + 1]) * (rr0[4 * g + 2] * rr0[4 * g + 3]); G[4 + g] = (rr1[4 * g] * rr1[4 * g + 1]) * (rr1[4 * g + 2] * rr1[4 * g + 3]); } \
            _Pragma("unroll") for (int g = 0; g < 8; ++g) { Gp[g] = partner(G[g]); T[g] = G[g] * Gp[g]; } \
            float suf = cq;          \
            _Pragma("unroll") for (int g = 7; g >= 0; --g) { \
                float bs = suf; if (hi == 0) bs *= Gp[g];       \
                if (g >= 4) { \
                    const int r = 4 * (g - 4); \
                    const float a3 = bs, a2 = a3 * rr1[r + 3], a1 = a2 * rr1[r + 2], a0 = a1 * rr1[r + 1]; \
                    C1[r + 3] = __builtin_fmaf(-a3, rr1[r + 3], a3); C1[r + 2] = __builtin_fmaf(-a2, rr1[r + 2], a2); C1[r + 1] = __builtin_fmaf(-a1, rr1[r + 1], a1); C1[r] = __builtin_fmaf(-a0, rr1[r], a0);        \
                } else { \
                    const int r = 4 * g; \
                    const float a3 = bs, a2 = a3 * rr0[r + 3], a1 = a2 * rr0[r + 2], a0 = a1 * rr0[r + 1]; \
                    C0[r + 3] = __builtin_fmaf(-a3, rr0[r + 3], a3); C0[r + 2] = __builtin_fmaf(-a2, rr0[r + 2], a2); C0[r + 1] = __builtin_fmaf(-a1, rr0[r + 1], a1); C0[r] = __builtin_fmaf(-a0, rr0[r], a0); \
                } \
                suf *= T[g]; \
            } \
            cq = suf; \
        } \
        if (!skp_) pv(o, vp0 + slot, C0, C1); \
        if (MODE == A_SB) { if (!wdead) wdead = __all(cq == 0.f); if (lane == 0) sbflag[(it & 1) * 8 + wid] = wdead ? 1u : 0u; } \
        if (MODE == A_FOX) {       \
            const float fk = t > 0 ? F2[kv0 - 1] : 0.f; \
            const bool dead = t > 0 && (smax + Fq - fk < mrun - 152.0f); \
            if (lane == 0) exflag[(it & 1) * 8 + wid] = __all(dead) ? 1u : 0u; \
        } \
        ATT_WAIT_BAR(); \
        if (MODE == A_FOX) { \
            unsigned alld = 1u; \
            _Pragma("unroll") for (int w = 0; w < 8; ++w) alld &= exflag[(it & 1) * 8 + w]; \
            if (alld) stop = true; \
        } \
        if (MODE == A_SB) {        \
            unsigned alld = 1u; \
            _Pragma("unroll") for (int w = 0; w < 8; ++w) alld &= sbflag[(it & 1) * 8 + w]; \
            if (alld) stop = true; \
        } \
    } while (0)
    for (int it2 = 0; it2 < NT; it2 += 2) {
        ATT_STEP(pA0, pA1, pB0, pB1, mwA, mwB, it2);
        if (stop) break;
        ATT_STEP(pB0, pB1, pA0, pA1, mwB, mwA, it2 + 1);
        if (stop) break;
    }
#undef ATT_STEP
#undef TILE_AT
    unsigned nx_ = 0u; const bool pop_ = (tid == 0);
    if (pop_) nx_ = __hip_atomic_fetch_add(qctr, 1u, RLX_AGENT);
    float rli[16];
    if (MODE == A_SB) {
#pragma unroll
        for (int r = 0; r < 16; ++r) rli[r] = 1.0f;
    } else {
        const float lt = lsum + partner(lsum);
        if (hi == 0) wsf[32 + r32] = lt;
#pragma unroll
        for (int r = 0; r < 16; ++r) rli[r] = 1.0f / wsf[32 + crow(r, hi)];
    }
    bf16* Ow = ACT + (rowbase + q0 + wid * QBLK) * ACTP + so * 64;
    {
        LAS bf16* stg = (LAS bf16*)(shm + LDS_OST) + wid * 2048;
#pragma unroll
        for (int r = 0; r < 16; ++r) { const int orow = crow(r, hi);
#pragma unroll
            for (int d0 = 0; d0 < 2; ++d0) stg[orow * 64 + d0 * 32 + r32] = (bf16)(cvtpk(o[d0][r] * rli[r], 0.f) & 0xffffu); }
        asm volatile("s_waitcnt lgkmcnt(0)" ::: "memory");
#pragma unroll
        for (int i = 0; i < 4; ++i) { const int row = i * 8 + (lane >> 3), ch = lane & 7; const u32x4 v = *(const LAS u32x4*)(stg + row * 64 + ch * 8); *(u32x4*)(Ow + (long)row * ACTP + ch * 8) = v; }
    }
    if (pop_) *nslot = nx_;
    ATT_WAIT_BAR();
#undef DMA_K
#undef DMA_V
}

constexpr int XL_K = 0, XL_V = 3 * SLOTB, XL_WS = 6 * SLOTB, XL_OST = XL_WS + NW * 256, XL_F = XL_OST + NW * 4096, XL_END = XL_F + 4096 * 4 + 128;
static_assert(XL_END <= RING_BYTES, "attention LDS");
template <int MODE, int THRL, bool FIX>
__device__ __forceinline__ void attn_unit_x(int b, int sq, int sk, int sv, int so, int qb, bf16* ACT, const bf16* KVH, const float* logf_bh, const unsigned* maskw, float smax, LAS char* shm, gu32* qctr, volatile LAS unsigned* nslot) {
    int tid = otid();
    const int lane = tid & 63, r32 = lane & 31, hi = lane >> 5; const int wid = __builtin_amdgcn_readfirstlane(tid >> 6);
    const long rowbase = (long)b * SEQ; const int q0 = qb * QB;
    const bf16* Qw = ACT + (rowbase + q0 + wid * QBLK) * ACTP + sq * 64;
    const bf16* Kh = KVH + ((size_t)sk * M + rowbase) * 64; const bf16* Vh = KVH + ((size_t)sv * M + rowbase) * 64;
    const unsigned lds0 = (unsigned)(uintptr_t)shm;
    LAS float* wsf = (LAS float*)(shm + XL_WS) + wid * 64;
    LAS float* F2 = (LAS float*)(shm + XL_F);
    LAS unsigned* exflag = (LAS unsigned*)(shm + XL_F + 4096 * 4 + 64);
    const bf16* ksrc = Kh + (long)lane * 64 + wid * 8;
    const bf16* vsrc = Vh + (long)(16 * (wid & 3) + (lane >> 2)) * 64 + (wid >> 2) * 32 + (lane & 3) * 8;
    const unsigned kdst = lds0 + XL_K + wid * 1024, vdst = lds0 + XL_V + wid * 1024;
    const int NT = (q0 + QB) / KVBLK;
#define TILE(i) ((MODE == A_FOX) ? NT - 1 - (i) : (i))
#define DMA_K(i, slot) glds16(ksrc + (long)TILE(i) * KVBLK * 64, (unsigned)__builtin_amdgcn_readfirstlane(kdst + (slot)))
#define DMA_V(i, slot) glds16(vsrc + (long)TILE(i) * KVBLK * 64, (unsigned)__builtin_amdgcn_readfirstlane(vdst + (slot)))
#define XWAIT_BAR(N) asm volatile("s_waitcnt vmcnt(" #N ") lgkmcnt(0)\n\ts_barrier" ::: "memory")
#define SBAR() __builtin_amdgcn_sched_barrier(0)
    lptr kp0 = (lptr)shm + XL_K + hi * 1024 + r32 * 16;
    lptr vp0 = (lptr)shm + XL_V + ((lane >> 4) & 1) * 32 + (lane & 3) * 8 + (4 * hi + ((lane & 15) >> 2)) * 64;
    DMA_K(0, 0); DMA_V(0, 0); DMA_K(1, SLOTB);
    bf16x8 qr[4];
#pragma unroll
    for (int d0 = 0; d0 < 4; ++d0) qr[d0] = *reinterpret_cast<const bf16x8*>(&Qw[(long)r32 * ACTP + d0 * 16 + hi * 8]);
    const int qabs = q0 + wid * QBLK + r32;
    float Fq = 0.f;
    if (MODE == A_FOX) {
        const int n = q0 + QB;
        float v[8]; float run = 0.f;
        if (8 * tid < n) { const f32x4 a = *(const f32x4*)(logf_bh + 8 * tid), c = *(const f32x4*)(logf_bh + 8 * tid + 4);
            v[0] = a[0]; v[1] = a[1]; v[2] = a[2]; v[3] = a[3]; v[4] = c[0]; v[5] = c[1]; v[6] = c[2]; v[7] = c[3]; }
        else {
#pragma unroll
            for (int j = 0; j < 8; ++j) v[j] = 0.f; }
#pragma unroll
        for (int j = 0; j < 8; ++j) { run += v[j]; v[j] = run; }
        float inc = run;
#pragma unroll
        for (int o_ = 1; o_ < 64; o_ <<= 1) { const float t_ = __int_as_float(__builtin_amdgcn_ds_bpermute(((lane >= o_ ? lane - o_ : lane)) << 2, __float_as_int(inc))); if (lane >= o_) inc += t_; }
        LAS float* wtot = (LAS float*)(shm + XL_F + 4096 * 4);
        if (lane == 63) wtot[wid] = inc;
        __syncthreads();
        float base = inc - run;
        for (int w = 0; w < wid; ++w) base += wtot[w];
        if (8 * tid < n) {
            *(LAS f32x4*)(F2 + 8 * tid) = (f32x4){(base + v[0]) * LOG2E, (base + v[1]) * LOG2E, (base + v[2]) * LOG2E, (base + v[3]) * LOG2E};
            *(LAS f32x4*)(F2 + 8 * tid + 4) = (f32x4){(base + v[4]) * LOG2E, (base + v[5]) * LOG2E, (base + v[6]) * LOG2E, (base + v[7]) * LOG2E};
        }
        __syncthreads();
        Fq = F2[qabs];
    }
    const unsigned* mwp = maskw + (size_t)qabs * 2 + hi;
    float mhat = 0.f; f32x16 o[2]; o[0] = f32x16{}; o[1] = f32x16{};
    f32x4 o2 = {0.f, 0.f, 0.f, 0.f}; bf16x8 BSEL; { LOCAL_U(one2_, 0x3f803f80u); const unsigned sel_ = ((((unsigned)lane >> 4) & 1u) == (((unsigned)lane >> 3) & 1u)) ? one2_ : 0u; const u32x4 t_ = {sel_, sel_, sel_, sel_}; BSEL = __builtin_bit_cast(bf16x8, t_); }
#define ROWSUM(k) o2 = __builtin_amdgcn_mfma_f32_16x16x32_bf16(PAF(k), BSEL, o2, 0, 0, 0)
    float msh = 0.f;
    LOCAL_F(NEGINF, -INFINITY);
    f32x16 negm = f32x16{};
    if (FIX) { msh = (MODE == A_FOX) ? smax - Fq : smax;
#pragma unroll
        for (int r = 0; r < 16; ++r) negm[r] = -msh; }
#define CINIT negm
    bool resc = false, stop = false, wdead = false;
    const int qlast_w = q0 + wid * QBLK + QBLK - 1;
#define APPLY(P0, P1, i, MW) do { const int T_ = TILE(i), kv0_ = T_ * KVBLK; \
        if (MODE == A_FOX) { _Pragma("unroll") for (int g = 0; g < 4; ++g) { \
            const f32x4 f0 = *(const LAS f32x4*)(F2 + kv0_ + 8 * g + 4 * hi), f1 = *(const LAS f32x4*)(F2 + kv0_ + 32 + 8 * g + 4 * hi); \
            _Pragma("unroll") for (int e = 0; e < 4; ++e) { P0[4 * g + e] -= f0[e]; P1[4 * g + e] -= f1[e]; } \
            SBAR(); } }        \
        if (MODE == A_DSA) {        \
            unsigned mw_ = (MW); \
            _Pragma("unroll") for (int r = 15; r >= 0; --r) { unsigned long long cm_; asm volatile("v_add_co_u32 %0, %1, %0, %0" : "+v"(mw_), "=s"(cm_)); P1[r] = __builtin_amdgcn_inverse_ballot_w64(cm_) ? P1[r] : NEGINF; } \
            _Pragma("unroll") for (int r = 15; r >= 0; --r) { unsigned long long cm_; asm volatile("v_add_co_u32 %0, %1, %0, %0" : "+v"(mw_), "=s"(cm_)); P0[r] = __builtin_amdgcn_inverse_ballot_w64(cm_) ? P0[r] : NEGINF; } } \
        if (MODE != A_DSA && kv0_ + KVBLK - 1 > qlast_w - (QBLK - 1)) {        _Pragma("unroll") for (int r = 0; r < 16; ++r) { const int kv = kv0_ + crow(r, hi); if (kv > qabs) P0[r] = NEGINF; if (kv + 32 > qabs) P1[r] = NEGINF; } } \
    } while (0)
#define RESC() do { if (resc) { asm volatile("s_waitcnt lgkmcnt(0)" ::: "memory"); \
        _Pragma("unroll") for (int d_ = 0; d_ < 2; ++d_) _Pragma("unroll") for (int r = 0; r < 16; ++r) o[d_][r] *= wsf[crow(r, hi)]; \
        _Pragma("unroll") for (int j_ = 0; j_ < 4; ++j_) o2[j_] *= wsf[4 * (lane >> 4) + j_ + 2 * (lane & 8)]; } } while (0)
    f32x16 pA0, pA1, pB0, pB1; bf16x8 kf[8]; s16x4 vlo[8], vhi[8]; u32x4 pw0, pw1, pw2, pw3;
    unsigned mwA = 0u, mwB = 0u;
    int sl_prev = 0, sl_cur = 0, sl_next = SLOTB;
#define ROT() do { sl_prev = sl_cur; sl_cur = sl_next; sl_next = (sl_next == 2 * SLOTB) ? 0 : sl_next + SLOTB; } while (0)
#define KLOAD2(j, kp) do { kf[2 * (j)] = *(const LAS bf16x8*)((kp) + (j) * 2048); kf[2 * (j) + 1] = *(const LAS bf16x8*)((kp) + (j) * 2048 + 512); } while (0)
    if (MODE == A_DSA) { mwA = mwp[(size_t)TILE(0) * SEQ * 2]; mwB = mwp[(size_t)TILE(1) * SEQ * 2]; }
    DMA_K(2, 2 * SLOTB);
    XWAIT_BAR(3);
    KLOAD2(0, kp0); KLOAD2(1, kp0); KLOAD2(2, kp0); KLOAD2(3, kp0);
    pA0 = MFMA32(kf[0], qr[0], CINIT); pA1 = MFMA32(kf[1], qr[0], CINIT); pA0 = MFMA32(kf[2], qr[1], pA0); pA1 = MFMA32(kf[3], qr[1], pA1);
    pA0 = MFMA32(kf[4], qr[2], pA0); pA1 = MFMA32(kf[5], qr[2], pA1); pA0 = MFMA32(kf[6], qr[3], pA0); pA1 = MFMA32(kf[7], qr[3], pA1);
    APPLY(pA0, pA1, 0, mwA);
    if (MODE == A_DSA) mwA = mwp[(size_t)TILE(2) * SEQ * 2];
    if (FIX) {
#pragma unroll
      for (int r = 0; r < 16; ++r) { pA0[r] = __builtin_amdgcn_exp2f(pA0[r]); pA1[r] = __builtin_amdgcn_exp2f(pA1[r]); }
    } else { const float rm = rowmax(pA0, pA1); const float dl = (rm > -3.0e38f) ? rm : 0.f; mhat += dl; msh = dl;
#pragma unroll
      for (int r = 0; r < 16; ++r) { pA0[r] = __builtin_amdgcn_exp2f(pA0[r] - dl); pA1[r] = __builtin_amdgcn_exp2f(pA1[r] - dl); negm[r] = -dl; } }
    XWAIT_BAR(0);
    DMA_K(3, 0); DMA_V(1, SLOTB);
    ROT();
    { lptr kp_ = kp0 + sl_cur; KLOAD2(0, kp_); KLOAD2(1, kp_); KLOAD2(2, kp_); KLOAD2(3, kp_); }
    XWAIT_BAR(2);
#define PKW(P, B) cvtpk(P[B], P[B + 1])
#define PAF(k) __builtin_bit_cast(bf16x8, pw##k)
#define VFR(i) (bf16x8){vlo[i][0], vlo[i][1], vlo[i][2], vlo[i][3], vhi[i][0], vhi[i][1], vhi[i][2], vhi[i][3]}
#define PIN(x) asm volatile("" : "+v"(x))
#define MX3(a, b, c) __builtin_fmaxf(__builtin_fmaxf((a), (b)), (c))
#define GAPA(MF, A0, A1, A2, A3, W0, W1, PW) do { MF; W0; W1; PIN(PW); SBAR(); } while (0)
#define EX(v) __builtin_amdgcn_exp2f(v)
#define GAPB(MF, X, B) do { MF; X[B] = EX(X[B]); X[B + 1] = EX(X[B + 1]); X[B + 2] = EX(X[B + 2]); X[B + 3] = EX(X[B + 3]); PIN(X); SBAR(); } while (0)
#define VRD(i) do { vlo[i] = vtr(vp_ + (((i) >> 2) * 4096 + ((i) & 3) * 1024)); vhi[i] = vtr(vp_ + (((i) >> 2) * 4096 + ((i) & 3) * 1024 + 512)); } while (0)
#define KRD(G, j) do { if (G) { KLOAD2(j, kp0 + sl_next); SBAR(); } } while (0)
#define STEP(C0, C1, P0, P1, MWC, i, GK, GV, GL) do { SBAR(); \
    if (MODE == A_DSA) { if ((i) + 2 < NT) MWC##n = mwp[(size_t)TILE((i) + 2) * SEQ * 2]; }        \
    const lptr vp_ = vp0 + sl_prev; \
    VRD(0); SBAR(); \
    GAPA(C0 = MFMA32(kf[0], qr[0], CINIT), P0[2], P0[3], P0[4], P0[5],     pw0[0] = PKW(P0, 0), pw0[1] = PKW(P0, 2), pw0); \
    VRD(4); SBAR(); GAPA(C1 = MFMA32(kf[1], qr[0], CINIT), P0[6], P0[7], P0[8], P0[9],     pw0[2] = PKW(P0, 4), pw0[3] = PKW(P0, 6), pw0); \
    VRD(1); SBAR(); GAPA(C0 = MFMA32(kf[2], qr[1], C0),   P0[10], P0[11], P0[12], P0[13], pw1[0] = PKW(P0, 8), pw1[1] = PKW(P0, 10), pw1); \
    VRD(5); SBAR(); GAPA(C1 = MFMA32(kf[3], qr[1], C1),   P0[14], P0[15], P1[0], P1[1],   pw1[2] = PKW(P0, 12), pw1[3] = PKW(P0, 14), pw1); \
    VRD(2); SBAR(); GAPA(C0 = MFMA32(kf[4], qr[2], C0),   P1[2], P1[3], P1[4], P1[5],     pw2[0] = PKW(P1, 0), pw2[1] = PKW(P1, 2), pw2); \
    VRD(6); SBAR(); GAPA(C1 = MFMA32(kf[5], qr[2], C1),   P1[6], P1[7], P1[8], P1[9],     pw2[2] = PKW(P1, 4), pw2[3] = PKW(P1, 6), pw2); \
    VRD(3); SBAR(); GAPA(C0 = MFMA32(kf[6], qr[3], C0),   P1[10], P1[11], P1[12], P1[13], pw3[0] = PKW(P1, 8), pw3[1] = PKW(P1, 10), pw3); \
    VRD(7); SBAR(); GAPA(C1 = MFMA32(kf[7], qr[3], C1),   P1[14], P1[15], 0.f, 0.f,       pw3[2] = PKW(P1, 12), pw3[3] = PKW(P1, 14), pw3); \
    if (GK) { DMA_K((i) + 3, sl_cur); } if (GV) { DMA_V((i) + 1, sl_next); } \
    APPLY(C0, C1, i, MWC); \
    if (FIX) { resc = false; } else { float a = MX3(C0[0], C0[1], C1[0]), b_ = MX3(C0[2], C0[3], C1[1]); a = MX3(a, C1[2], C1[3]); \
      _Pragma("unroll") for (int r = 4; r < 16; r += 4) { a = MX3(a, C0[r], C0[r + 1]); b_ = MX3(b_, C0[r + 2], C0[r + 3]); a = MX3(a, C1[r], C1[r + 1]); b_ = MX3(b_, C1[r + 2], C1[r + 3]); } \
      float rm = __builtin_fmaxf(a, b_); { auto rr = __builtin_amdgcn_permlane32_swap(__float_as_uint(rm), __float_as_uint(rm), false, false); rm = __builtin_fmaxf(__uint_as_float(rr[0]), __uint_as_float(rr[1])); } \
      resc = false; \
      if (__builtin_expect(__any(rm > (float)THRL), 0)) { const float dl = __builtin_fmaxf(rm, 0.f); mhat += dl; msh += dl; \
        _Pragma("unroll") for (int r = 0; r < 16; ++r) { negm[r] -= dl; C0[r] -= dl; C1[r] -= dl; }        \
        const float f = __builtin_amdgcn_exp2f(-dl); if (hi == 0) { int r32_o = r32; asm volatile("" : "+v"(r32_o)); wsf[r32_o] = f; } resc = true; } } \
    SBAR(); \
    GAPB(o[0] = MFMA32(PAF(0), VFR(0), o[0]), C0, 0); \
    GAPB(o[1] = MFMA32(PAF(0), VFR(4), o[1]); ROWSUM(0), C0, 4); \
    KRD(GL, 0); GAPB(o[0] = MFMA32(PAF(1), VFR(1), o[0]), C0, 8); \
    KRD(GL, 1); GAPB(o[1] = MFMA32(PAF(1), VFR(5), o[1]); ROWSUM(1), C0, 12); \
    KRD(GL, 2); GAPB(o[0] = MFMA32(PAF(2), VFR(2), o[0]), C1, 0); \
    KRD(GL, 3); GAPB(o[1] = MFMA32(PAF(2), VFR(6), o[1]); ROWSUM(2), C1, 4); \
    GAPB(o[0] = MFMA32(PAF(3), VFR(3), o[0]), C1, 8); \
    GAPB(o[1] = MFMA32(PAF(3), VFR(7), o[1]); ROWSUM(3), C1, 12); \
    if (MODE == A_FOX) {       \
        const int T_ = TILE(i); const float fk = T_ > 0 ? F2[T_ * KVBLK - 1] : 0.f; \
        const bool dead = T_ > 0 && (smax - fk < msh - 152.0f);        \
        const bool wd_ = __all(dead); wdead = wdead || wd_; \
        if (lane == 0) exflag[((i) & 1) * 8 + wid] = wd_ ? 1u : 0u; } \
    } while (0)
#define STEP_SKIP(C0, C1, MWC, i, GK, GV, GL) do { SBAR(); \
    if (MODE == A_DSA) { if ((i) + 2 < NT) MWC##n = mwp[(size_t)TILE((i) + 2) * SEQ * 2]; } \
    if (GK) { DMA_K((i) + 3, sl_cur); } if (GV) { DMA_V((i) + 1, sl_next); } \
    if (GL) { KLOAD2(0, kp0 + sl_next); KLOAD2(1, kp0 + sl_next); KLOAD2(2, kp0 + sl_next); KLOAD2(3, kp0 + sl_next); } \
    _Pragma("unroll") for (int r = 0; r < 16; ++r) { C0[r] = 0.f; C1[r] = 0.f; } \
    resc = false; \
    if (MODE == A_FOX) { if (lane == 0) exflag[((i) & 1) * 8 + wid] = wdead ? 1u : 0u; } \
    } while (0)
#define LIVE(i) (!(TILE(i) * KVBLK > qlast_w) && !wdead)
#define ENDW(i) do { if ((i) + 3 < NT) { XWAIT_BAR(2); } else if ((i) + 2 < NT) { XWAIT_BAR(1); } else { XWAIT_BAR(0); }        \
        if (MODE == A_FOX) { unsigned alld = 1u; _Pragma("unroll") for (int w = 0; w < 8; ++w) alld &= exflag[((i) & 1) * 8 + w]; if (alld) stop = true; } } while (0)
#define DRAIN(P0, P1) do { \
        pw0 = (u32x4){PKW(P0, 0), PKW(P0, 2), PKW(P0, 4), PKW(P0, 6)}; pw1 = (u32x4){PKW(P0, 8), PKW(P0, 10), PKW(P0, 12), PKW(P0, 14)}; \
        pw2 = (u32x4){PKW(P1, 0), PKW(P1, 2), PKW(P1, 4), PKW(P1, 6)}; pw3 = (u32x4){PKW(P1, 8), PKW(P1, 10), PKW(P1, 12), PKW(P1, 14)}; \
        const lptr vp_ = vp0 + sl_cur; _Pragma("unroll") for (int i_ = 0; i_ < 8; ++i_) VRD(i_); \
        o[0] = MFMA32(PAF(0), VFR(0), o[0]); o[1] = MFMA32(PAF(0), VFR(4), o[1]); o[0] = MFMA32(PAF(1), VFR(1), o[0]); o[1] = MFMA32(PAF(1), VFR(5), o[1]); \
        o[0] = MFMA32(PAF(2), VFR(2), o[0]); o[1] = MFMA32(PAF(2), VFR(6), o[1]); o[0] = MFMA32(PAF(3), VFR(3), o[0]); o[1] = MFMA32(PAF(3), VFR(7), o[1]); \
        ROWSUM(0); ROWSUM(1); ROWSUM(2); ROWSUM(3); } while (0)
    unsigned mwAn = 0u, mwBn = 0u;
    int i = 1, ilast = NT - 1;
    bool pzero = !LIVE(0);
    for (; i + 1 < NT; i += 2) {
        { const bool lc_ = LIVE(i);
          if (MODE != A_FOX || lc_ || !pzero) STEP(pB0, pB1, pA0, pA1, mwB, i, (i + 3 < NT), (i + 1 < NT), (i + 1 < NT)); else STEP_SKIP(pB0, pB1, mwB, i, (i + 3 < NT), (i + 1 < NT), (i + 1 < NT));
          pzero = !lc_; }
        ENDW(i);     RESC(); mwB = mwBn; ROT();
        { const bool lc_ = LIVE(i + 1);
          if (MODE != A_FOX || lc_ || !pzero) STEP(pA0, pA1, pB0, pB1, mwA, i + 1, (i + 4 < NT), (i + 2 < NT), (i + 2 < NT)); else STEP_SKIP(pA0, pA1, mwA, i + 1, (i + 4 < NT), (i + 2 < NT), (i + 2 < NT));
          pzero = !lc_; }
        ENDW(i + 1); RESC(); mwA = mwAn; ROT();
        if (stop) {
            ilast = i + 2; XWAIT_BAR(0); break; }
    }
    STEP(pB0, pB1, pA0, pA1, mwB, ilast, false, false, false); RESC(); DRAIN(pB0, pB1);
    unsigned nx_ = 0u; const bool pop_ = (tid == 0);
    if (pop_) nx_ = __hip_atomic_fetch_add(qctr, 1u, RLX_AGENT);
    if ((lane & 7) == 0) {
#pragma unroll
        for (int j_ = 0; j_ < 4; ++j_) wsf[32 + 4 * (lane >> 4) + j_ + 2 * (lane & 8)] = o2[j_]; }
    asm volatile("s_waitcnt lgkmcnt(0)" ::: "memory");
    float rli[16];
#pragma unroll
    for (int r = 0; r < 16; ++r) rli[r] = __builtin_amdgcn_rcpf(wsf[32 + crow(r, hi)]);
    bf16* Ow = ACT + (rowbase + q0 + wid * QBLK) * ACTP + so * 64;
    {
        LAS bf16* stg = (LAS bf16*)(shm + XL_OST) + wid * 2048;
#pragma unroll
        for (int r = 0; r < 16; ++r) { const int orow = crow(r, hi);
#pragma unroll
            for (int d0 = 0; d0 < 2; ++d0) stg[orow * 64 + d0 * 32 + r32] = (bf16)(cvtpk(o[d0][r] * rli[r], 0.f) & 0xffffu); }
        asm volatile("s_waitcnt lgkmcnt(0)" ::: "memory");
#pragma unroll
        for (int i_ = 0; i_ < 4; ++i_) { const int row = i_ * 8 + (lane >> 3), ch = lane & 7; const u32x4 v = *(const LAS u32x4*)(stg + row * 64 + ch * 8); *(u32x4*)(Ow + (long)row * ACTP + ch * 8) = v; }
    }
    if (pop_) *nslot = nx_;
    asm volatile("s_waitcnt lgkmcnt(0)\n\ts_barrier" ::: "memory");
#undef CINIT
#undef ROWSUM
#undef LIVE
#undef STEP_SKIP
#undef TILE
#undef DMA_K
#undef DMA_V
#undef XWAIT_BAR
#undef SBAR
#undef APPLY
#undef RESC
#undef ROT
#undef KLOAD2
#undef PKW
#undef PAF
#undef VFR
#undef PIN
#undef MX3
#undef GAPA
#undef EX
#undef GAPB
#undef VRD
#undef KRD
#undef STEP
#undef ENDW
#undef DRAIN
}

constexpr int SEL_CAP = 128, SEL_LW = 132, SEL_HW = 257;
constexpr unsigned SEL_Z = 0x80000000u;
constexpr int SEL_PB = 5903, SEL_NB = 986;
constexpr int SEL_K = 0, SEL_HIST = 65536, SEL_LIST = SEL_HIST + 32768, SEL_ST = SEL_LIST + 64 * SEL_LW * 4, SEL_PS = SEL_ST + 12 * 256, SEL_END = SEL_PS + 64 * 8 * 4;
static_assert(SEL_ST >= SEL_HIST + 64 * SEL_HW * 4, "select LDS map");
static_assert(SEL_END <= MISC_OFF, "select LDS");
__device__ __forceinline__ unsigned sortkey(float s) { const unsigned u = __float_as_uint(s); return u ^ ((unsigned)((int)u >> 31) | 0x80000000u); }
typedef unsigned long long u64;
__device__ __forceinline__ float relu_(float x) { const int b = __float_as_int(x); return __int_as_float(b > 0 ? b : 0); }
__device__ __forceinline__ unsigned sel_shift(unsigned W) { const unsigned lg = W <= 1u ? 0u : 32u - (unsigned)__builtin_clz(W - 1u); return lg > 8u ? lg - 8u : 0u; }

__device__ __forceinline__ void select_unit(int b, int qi, const bf16* ACT, const bf16* KVH, const float* WI, unsigned* maskw_b, LAS char* shm, gu32* qctr, volatile LAS unsigned* nslot, gu32* ready) {
    int tid = otid();
    const int lane = tid & 63, r32 = lane & 31, hi = lane >> 5; const int wid = __builtin_amdgcn_readfirstlane(tid >> 6);
    const int qsub = wid & 1, kph = wid >> 1;
    const long rowbase = (long)b * SEQ; const int q0 = qi * 64;
    const int qloc = qsub * 32 + r32, qabs = q0 + qloc;
    const int NTs = qi + 1, nsteps = (NTs + 3) >> 2;
    const unsigned lds0 = (unsigned)(uintptr_t)shm;
    LAS unsigned* hist = (LAS unsigned*)(shm + SEL_HIST);
    LAS unsigned* mlds = (LAS unsigned*)(shm + SEL_HIST);
    LAS unsigned* list = (LAS unsigned*)(shm + SEL_LIST);
    LAS unsigned* st_lo = (LAS unsigned*)(shm + SEL_ST); LAS unsigned* st_wd = st_lo + 64; LAS unsigned* st_sh = st_lo + 128; LAS unsigned* st_need = st_lo + 192;
    LAS unsigned* st_state = st_lo + 256; LAS unsigned* st_ilo = st_lo + 320; LAS unsigned* st_iwd = st_lo + 384; LAS unsigned* st_cnt = st_lo + 448; LAS unsigned* st_mode = st_lo + 512; LAS unsigned* flag = st_lo + 576;
    LAS unsigned* psum = (LAS unsigned*)(shm + SEL_PS);
    const bf16* Qw = ACT + (rowbase + qabs) * ACTP + A_IQ * 64;
    bf16x8 qf[4][4];
#pragma unroll
    for (int h = 0; h < 4; ++h)
#pragma unroll
        for (int d0 = 0; d0 < 4; ++d0) qf[h][d0] = *reinterpret_cast<const bf16x8*>(&Qw[h * 64 + d0 * 16 + hi * 8]);
    const f32x4 wv = *(const f32x4*)(WI + (size_t)(rowbase + qabs) * 4);
    const bf16* ksrc = KVH + ((size_t)KV_IK * M + rowbase + lane) * 64 + wid * 8;
    const unsigned kdst = lds0 + SEL_K + wid * 1024;
    lptr kbase = (lptr)shm + SEL_K;
#define SEL_DMA(s, slot) do { _Pragma("unroll") for (int j_ = 0; j_ < 4; ++j_) { const int t_ = 4 * (s) + j_; if (t_ < NTs) glds16(ksrc + (long)t_ * 64 * 64, (unsigned)__builtin_amdgcn_readfirstlane(kdst + (slot) + j_ * 8192)); } } while (0)
    LOCAL_I(c256, 256);
    if (tid < 64) { const bool all = (q0 + tid) < c256; st_lo[tid] = 0u; st_wd[tid] = 0u; st_sh[tid] = 0u; st_need[tid] = (unsigned)c256; st_state[tid] = all ? 2u : 0u; st_cnt[tid] = 0u; }
    for (int i = tid; i < (SEL_ST - SEL_HIST) / 4; i += 512) hist[i] = 0u;
    if (tid == 0) flag[0] = (q0 + 63 < 256) ? 1u : 0u;
    __syncthreads();
    bool fin = flag[0] != 0u;
    for (int pass = 0; pass < 14; ++pass) {
        if (pass == 13) fin = true;
        const unsigned lo = st_lo[qloc], wd = st_wd[qloc], shv = st_sh[qloc];
        const bool active = st_state[qloc] == 0u;
        const bool tbm = st_state[qloc] == 3u;
        const unsigned rwid = active ? wd : 0u;
        const unsigned upk = (lo + wd < lo) ? 0xffffffffu : lo + wd;
        LAS unsigned* hrow = hist + qloc * SEL_HW;
        const int kind = fin ? 2 : pass == 0 ? 0 : 1;
#define SEL_COLLECT(kv_, key_) do { \
            if (st_state[qloc] == 3u) __hip_atomic_fetch_or(&list[qloc * SEL_LW + ((kv_) >> 5)], 1u << ((kv_) & 31), __ATOMIC_RELAXED, __HIP_MEMORY_SCOPE_WORKGROUP); \
            else { const unsigned e = __hip_atomic_fetch_add(&st_cnt[qloc], 1u, __ATOMIC_RELAXED, __HIP_MEMORY_SCOPE_WORKGROUP); if (e < (unsigned)SEL_CAP) list[qloc * SEL_LW + e] = (((key_) - lo) << 12) | (unsigned)(4095 - (kv_)); } } while (0)
#define SEL_BIN0(key_, bin_) \
            int bp_ = (int)((key_) >> 19) - cPB; bp_ = bp_ < 0 ? 0 : bp_ > c351 ? c351 : bp_; \
            int bn_ = (int)((key_) >> 20) - cNB; bn_ = bn_ < 0 ? 0 : bn_ > c158 ? c158 : bn_; \
            const int bin_ = (key_) > SEL_Z ? c160 + bp_ : (key_) == SEL_Z ? c159 : bn_;
#define SEL_TILE(KIND, DIAG) do { \
            int t_o = t; asm volatile("" : "+s"(t_o));        \
            LOCAL_I(c351, 351); LOCAL_I(c158, 158); LOCAL_I(c159, 159); LOCAL_I(c160, 160); LOCAL_I(cPB, SEL_PB); LOCAL_I(cNB, SEL_NB);        \
            int kvb = t_o * 64 + 4 * hi; asm volatile("" : "+v"(kvb));        \
            unsigned cw = 0u;                                 \
            if (DIAG) { const int ql_ = qabs - kvb; _Pragma("unroll") for (int i = 31; i >= 0; --i) asm("v_cmp_ge_i32 vcc, %1, %2\n\tv_addc_co_u32 %0, vcc, %0, %0, vcc" : "+v"(cw) : "v"(ql_), "n"((i & 3) + 8 * ((i & 15) >> 2) + 32 * (i >> 4)) : "vcc"); } \
            unsigned word = 0u; \
            lptr kb = kbase + slot + kph * 8192 + hi * 1024 + r32 * 16; \
            _Pragma("unroll") for (int half = 0; half < 2; ++half) { \
                bf16x8 kf[4]; \
                _Pragma("unroll") for (int d0 = 0; d0 < 4; ++d0) kf[d0] = *(const LAS bf16x8*)(kb + d0 * 2048 + half * 512); \
                f32x16 sc = f32x16{}; \
                _Pragma("unroll") for (int h = 0; h < 4; ++h) { \
                    f32x16 d = f32x16{}; \
                    _Pragma("unroll") for (int d0 = 0; d0 < 4; ++d0) d = MFMA32(kf[d0], qf[h][d0], d); \
                    const float w = wv[h]; \
                    _Pragma("unroll") for (int r = 0; r < 16; ++r) sc[r] += w * relu_(d[r]); \
                } \
                if (KIND == 2) { \
                    unsigned dmin = 0xffffffffu; \
                    _Pragma("unroll") for (int r = 15; r >= 0; --r) {         \
                        const unsigned key = sortkey(sc[r]); \
                        asm("v_cmp_le_u32 vcc, %2, %1\n\tv_addc_co_u32 %0, vcc, %0, %0, vcc" : "+v"(word) : "v"(key), "v"(upk) : "vcc"); \
                        dmin = min(dmin, key - lo); \
                    } \
                    if (dmin < wd) {                                          \
                        _Pragma("unroll") for (int r8 = 0; r8 < 16; r8 += 8) { \
                            unsigned ee[8]; \
                            _Pragma("unroll") for (int j_ = 0; j_ < 8; ++j_) { const int r = r8 + j_; \
                                const int kv = kvb + (r & 3) + 8 * (r >> 2) + 32 * half; const unsigned key = sortkey(sc[r]); ee[j_] = 0xffffffffu; \
                                if ((key - lo) < wd && (!(DIAG) || __builtin_amdgcn_ubfe(cw, 16 * half + r, 1))) { \
                                    if (tbm) __hip_atomic_fetch_or(&list[qloc * SEL_LW + (kv >> 5)], 1u << (kv & 31), __ATOMIC_RELAXED, __HIP_MEMORY_SCOPE_WORKGROUP); \
                                    else ee[j_] = __hip_atomic_fetch_add(&st_cnt[qloc], 1u, __ATOMIC_RELAXED, __HIP_MEMORY_SCOPE_WORKGROUP); } } \
                            _Pragma("unroll") for (int j_ = 0; j_ < 8; ++j_) { const int r = r8 + j_; \
                                const int kv = kvb + (r & 3) + 8 * (r >> 2) + 32 * half; const unsigned key = sortkey(sc[r]); \
                                if (ee[j_] < (unsigned)SEL_CAP) list[qloc * SEL_LW + ee[j_]] = ((key - lo) << 12) | (unsigned)(4095 - kv); } \
                        } \
                    } \
                } else if (KIND == 0) {                                        \
                    _Pragma("unroll") for (int r = 0; r < 16; ++r) { \
                        const unsigned key = sortkey(sc[r]); \
                        SEL_BIN0(key, bin) \
                        const unsigned one = (DIAG) ? __builtin_amdgcn_ubfe(cw, 16 * half + r, 1) : 1u; \
                        __hip_atomic_fetch_add(&hrow[bin >> 1], one << (16 * (bin & 1)), __ATOMIC_RELAXED, __HIP_MEMORY_SCOPE_WORKGROUP); \
                    } \
                } else { \
                    _Pragma("unroll") for (int r = 0; r < 16; ++r) { \
                        const unsigned key = sortkey(sc[r]); \
                        const unsigned dv = key - lo;        \
                        const unsigned one = (DIAG) ? __builtin_amdgcn_ubfe(cw, 16 * half + r, 1) : 1u; \
                        if (dv < rwid) { const unsigned g = dv >> shv; __hip_atomic_fetch_add(&hrow[g >> 1], one << (16 * (g & 1u)), __ATOMIC_RELAXED, __HIP_MEMORY_SCOPE_WORKGROUP); } \
                    } \
                } \
            } \
            if (KIND == 2) { word = (word >> 16) | (word << 16); if (DIAG) word &= cw; mlds[(t_o * 64 + qloc) * 2 + hi] = word; } \
        } while (0)
#define SEL_SWEEP(KIND) do { \
        SEL_DMA(0, 0); \
        ATT_WAIT_BAR(); \
        for (int s = 0; s < nsteps; ++s) { \
            const int slot = (s & 1) * 32768; \
            if (s + 1 < nsteps) SEL_DMA(s + 1, 32768 - slot); \
            const int t = 4 * s + kph; \
            if (t < qi) SEL_TILE(KIND, 0); \
            else if (t == qi) SEL_TILE(KIND, 1); \
            ATT_WAIT_BAR(); \
        } } while (0)
        if (kind == 2) { SEL_SWEEP(2);
            if (SELP == 2) { __syncthreads(); if (tid < 64) st_cnt[tid] = 0u; __syncthreads(); SEL_SWEEP(2); } }
        else if (kind == 0) { SEL_SWEEP(0); }
        else { SEL_SWEEP(1);
            if (SELP == 3) { __syncthreads(); for (int i = tid; i < 64 * SEL_HW; i += 512) hist[i] = 0u; __syncthreads(); SEL_SWEEP(1); } }
#undef SEL_SWEEP
#undef SEL_TILE
#undef SEL_BIN0
#undef SEL_COLLECT
        if (fin) break;
        {
            const int row = tid >> 3, part = tid & 7;
            unsigned sacc = 0u;
#pragma unroll
            for (int w = 0; w < 32; ++w) { const unsigned x = hist[row * SEL_HW + part * 32 + w]; sacc += (x & 0xffffu) + (x >> 16); }
            psum[row * 8 + part] = sacc;
        }
        __syncthreads();
        if (tid < 64) {
            const int row = tid;
            unsigned state = st_state[row];
            if (state == 0u) {
                unsigned need = st_need[row], cum = 0u; int part = 7;
                for (; part > 0; --part) { const unsigned c = psum[row * 8 + part]; if (cum + c >= need) break; cum += c; }
                int dstar = part * 64; unsigned cbin = 0u;
                for (int w = 31; w >= 0; --w) {
                    const unsigned x = hist[row * SEL_HW + part * 32 + w]; const unsigned co = x >> 16, ce = x & 0xffffu;
                    if (cum + co >= need) { dstar = part * 64 + 2 * w + 1; cbin = co; break; } cum += co;
                    if (cum + ce >= need) { dstar = part * 64 + 2 * w; cbin = ce; break; } cum += ce;
                }
                need -= cum;
                unsigned L, W;
                LOCAL_I(sPB, SEL_PB); LOCAL_I(sNB, SEL_NB);
                if (kind == 0) {
                    if (dstar >= 160) { const int bp = dstar - 160;
                        if (bp == 0) { L = SEL_Z + 1u; W = ((unsigned)(SEL_PB + 1) << 19) - L; }
                        else if (bp == 351) { L = (unsigned)(SEL_PB + 351) << 19; W = 0u - L; }
                        else { L = (unsigned)(sPB + bp) << 19; W = 1u << 19; } }
                    else if (dstar == 159) { L = SEL_Z; W = 1u; }
                    else { const int bn = dstar;
                        if (bn == 0) { L = 0u; W = (unsigned)(SEL_NB + 1) << 20; }
                        else if (bn == 158) { L = (unsigned)(SEL_NB + 158) << 20; W = SEL_Z - L; }
                        else { L = (unsigned)(sNB + bn) << 20; W = 1u << 20; } }
                } else {
                    const unsigned lo_r = st_lo[row], wd_r = st_wd[row], sh_r = st_sh[row];
                    L = lo_r + ((unsigned)dstar << sh_r); W = min(1u << sh_r, lo_r + wd_r - L);
                }
                if (cbin == need) { state = 2u; W = 0u; }
                else if (cbin <= (unsigned)SEL_CAP && W <= (1u << 20)) state = 1u;
                else if (W == 1u) state = 3u;
                st_lo[row] = L; st_wd[row] = W; st_sh[row] = sel_shift(W);
                st_need[row] = need; st_state[row] = state;
            }
            const bool anyp = __any(state == 0u);
            if (tid == 0) flag[0] = anyp ? 0u : 1u;
        }
        __syncthreads();
        for (int i = tid; i < 64 * SEL_HW; i += 512) hist[i] = 0u;
        __syncthreads();
        fin = flag[0] != 0u;
    }
    unsigned nx_ = 0u; const bool pop_ = (tid == 0);
    if (pop_) nx_ = __hip_atomic_fetch_add(qctr, 1u, RLX_AGENT);
    {
        const int row = tid >> 3, part = tid & 7;
        const unsigned stt = st_state[row], need = st_need[row];
        const LAS unsigned* lr = list + row * SEL_LW;
        unsigned bcnt = 0u;
        if (stt == 3u) {
#pragma unroll
            for (int w = 0; w < 16; ++w) bcnt += (unsigned)__builtin_popcount(lr[part * 16 + w]);
        }
        psum[row * 8 + part] = bcnt;
        __syncthreads();
        if (stt == 1u) {
            const unsigned n = min(st_cnt[row], (unsigned)SEL_CAP);
            LOCAL_U(c4095, 4095u);
            for (unsigned e = part; e < n; e += 16) {
                const unsigned c0 = lr[e]; const bool has1 = e + 8 < n; const unsigned c1 = has1 ? lr[e + 8] : 0xffffffffu;
                unsigned r0 = 0u, r1 = 0u;
                for (unsigned j = 0; j < n; j += 4) {
                    const u32x4 x = *(const LAS u32x4*)(lr + j);
                    r0 += (x[0] > c0 ? 1u : 0u) + (x[1] > c0 ? 1u : 0u) + (x[2] > c0 ? 1u : 0u) + (x[3] > c0 ? 1u : 0u);
                    r1 += (x[0] > c1 ? 1u : 0u) + (x[1] > c1 ? 1u : 0u) + (x[2] > c1 ? 1u : 0u) + (x[3] > c1 ? 1u : 0u);
                }
#pragma unroll
                for (int w = 0; w < 2; ++w) {
                    const unsigned c = w ? c1 : c0, rank = w ? r1 : r0;
                    if ((w == 0 || has1) && rank < need) {
                        const int kv = (int)(c4095 - (c & c4095)), t = kv >> 6, k32 = kv & 31, half = (kv >> 5) & 1, hi_ = (k32 >> 2) & 1, r = (k32 & 3) + 4 * (k32 >> 3);
                        __hip_atomic_fetch_or(&mlds[(t * 64 + row) * 2 + hi_], 1u << (16 * half + r), __ATOMIC_RELAXED, __HIP_MEMORY_SCOPE_WORKGROUP);
                    }
                }
            }
        } else if (stt == 3u) {
            unsigned before = 0u;
            for (int p = 0; p < part; ++p) before += psum[row * 8 + p];
            for (int w = 0; w < 16 && before < need; ++w) {
                unsigned x = lr[part * 16 + w];
                while (x != 0u && before < need) {
                    const int bit = __builtin_ctz(x); x &= x - 1u; ++before;
                    const int kv = (part * 16 + w) * 32 + bit, t = kv >> 6, k32 = kv & 31, half = (kv >> 5) & 1, hi_ = (k32 >> 2) & 1, r = (k32 & 3) + 4 * (k32 >> 3);
                    __hip_atomic_fetch_or(&mlds[(t * 64 + row) * 2 + hi_], 1u << (16 * half + r), __ATOMIC_RELAXED, __HIP_MEMORY_SCOPE_WORKGROUP);
                }
            }
        }
    }
    __syncthreads();
    for (int i = tid; i < NTs * 128; i += 512) { const int t = i >> 7, rem = i & 127; maskw_b[((size_t)t * SEQ + q0) * 2 + rem] = mlds[i]; }
    for (int i = NTs * 128 + tid; i < ((qi >> 2) * 4 + 4) * 128; i += 512) { const int t = i >> 7, rem = i & 127; maskw_b[((size_t)t * SEQ + q0) * 2 + rem] = 0u; }
    if (pop_) *nslot = nx_;
    ATT_WAIT_BAR();
    if (tid == 0) { __builtin_amdgcn_fence(__ATOMIC_RELEASE, "agent"); asm volatile("s_waitcnt vmcnt(0)" ::: "memory"); (void)__hip_atomic_fetch_add(ready, 1u, RLX_AGENT); }
#undef SEL_DMA
}
#undef ATT_WAIT_BAR
#undef MFMA32
}

#define XB_TMO      128
#define XB_XCNT(j)  (256  + 64 * (j))
#define XB_XSUB(j)  (1280 + 64 * (j))
#define XB_XGEN(j)  (2304 + 64 * (j))
#define XB_TOP      3328
#define XB_TOPGEN   3392
#define XCD_BAR_WORDS 3456
#define XB_SPIN_CAP (1u << 18)
__device__ __forceinline__ unsigned xb_ld(unsigned* p)              { return __hip_atomic_load(p, __ATOMIC_RELAXED, __HIP_MEMORY_SCOPE_AGENT); }
__device__ __forceinline__ unsigned xb_add(unsigned* p, unsigned v) { return __hip_atomic_fetch_add(p, v, __ATOMIC_RELAXED, __HIP_MEMORY_SCOPE_AGENT); }
__device__ __forceinline__ unsigned xb_xcc_id() { return (unsigned)__builtin_amdgcn_s_getreg((3 << 11) | 20) & 0xFu; }
#define XB_SPIN(cond, bar) do { unsigned _sp = 0; while (cond) { __builtin_amdgcn_s_sleep(1); \
    if ((++_sp & 255u) == 0u) { if (xb_ld(&(bar)[XB_TMO])) break; if (_sp > XB_SPIN_CAP) { atomicAdd(&(bar)[XB_TMO], 1u); break; } } } } while (0)
struct XcdBarrier { unsigned* bar; unsigned x; volatile LAS unsigned* st; };
__device__ __forceinline__ XcdBarrier xcd_barrier_post(unsigned* bar, volatile LAS unsigned* st) {
    XcdBarrier b; b.bar = bar; b.x = xb_xcc_id(); b.st = st;
    if (otid() == 0) { (void)xb_add(&bar[XB_XCNT(b.x)], 1u); st[2] = b.x; }
    return b;
}
__device__ __forceinline__ void xcd_barrier_complete(unsigned* bar, unsigned x, unsigned& nloc, unsigned& nx) {
    const unsigned G = gridDim.x * gridDim.y * gridDim.z;
    unsigned sum, cnt, mine, sp = 0u;
    for (;;) {
        sum = 0u; cnt = 0u; mine = 0u;
#pragma unroll
        for (unsigned j = 0; j < 16; ++j) { const unsigned c = xb_ld(&bar[XB_XCNT(j)]); sum += c; cnt += (c > 0u) ? 1u : 0u; mine = (j == x) ? c : mine; }
        if (sum == G) break;
        __builtin_amdgcn_s_sleep(1);
        if ((++sp & 255u) == 0u) { if (xb_ld(&bar[XB_TMO])) break; if (sp > XB_SPIN_CAP) { atomicAdd(&bar[XB_TMO], 1u); break; } }
    }
    nloc = mine > 0u ? mine : 1u; nx = cnt > 0u ? cnt : 1u;
}
__device__ __forceinline__ void xcd_barrier(const XcdBarrier& b) {
    asm volatile("s_waitcnt vmcnt(0)" ::: "memory");
    __syncthreads();
    if (otid() == 0) {
        unsigned* bar = b.bar;
        __builtin_amdgcn_s_waitcnt(0);
        unsigned nloc = b.st[0], nx = b.st[1];
        const unsigned bx_ = b.st[2];
        if (nloc == 0u) { xcd_barrier_complete(bar, bx_, nloc, nx); b.st[0] = nloc; b.st[1] = nx; }
        const unsigned old = xb_add(&bar[XB_XSUB(bx_)], 1u);
        const unsigned gen = old / nloc;
        if (old + 1u == (gen + 1u) * nloc) {
            __builtin_amdgcn_fence(__ATOMIC_RELEASE, "agent");
            asm volatile("s_waitcnt vmcnt(0)" ::: "memory");
            const unsigned og = xb_add(&bar[XB_TOP], 1u);
            const unsigned tg = og / nx;
            if (og + 1u == (tg + 1u) * nx) xb_add(&bar[XB_TOPGEN], 1u);
            else XB_SPIN(xb_ld(&bar[XB_TOPGEN]) == tg, bar);
            __builtin_amdgcn_fence(__ATOMIC_ACQUIRE, "agent");
            xb_add(&bar[XB_XGEN(bx_)], 1u);
            asm volatile("s_waitcnt vmcnt(0)" ::: "memory");
        } else {
            XB_SPIN(xb_ld(&bar[XB_XGEN(bx_)]) == gen, bar);
            __builtin_amdgcn_fence(__ATOMIC_ACQUIRE, "agent");
            asm volatile("s_waitcnt vmcnt(0)" ::: "memory");
        }
    }
    __syncthreads();
}

__device__ __forceinline__ float wave_sum(float v) {
#pragma unroll
    for (int o = 1; o < 64; o <<= 1) v += __shfl_xor(v, o);
    return v;
}
__device__ __forceinline__ int win_src_col(int p) {
    const int tile = p >> 8, bj = (p >> 7) & 1, wc = (p >> 5) & 3, j = p & 31, slot = tile * 4 + wc;
    int d = 32 * bj + j;
    const bool rope = (slot >= SL_CQ && slot < SL_FK) || (slot >= SL_CK && slot < SL_FV) || (slot >= SL_IQ && slot <= SL_IK);
    if (rope) { if (d >= 8 && d < 16) d += 24; else if (d >= 32 && d < 40) d -= 24; }
    if (slot < 6) return 0 + 64 * slot + d;
    if (slot < 12) return 1158 + 64 * (slot - 6) + d;
    if (slot < 16) return 2310 + 64 * (slot - 12) + d;
    if (slot < 22) return 384 + 64 * (slot - 16) + d;
    if (slot < 28) return 1542 + 64 * (slot - 22) + d;
    if (slot < 32) return 2566 + 64 * (slot - 28) + d;
    if (slot < 38) return 768 + 64 * (slot - 32) + d;
    if (slot < 44) return 1926 + 64 * (slot - 38) + d;
    if (slot < 48) return 2822 + 64 * (slot - 44) + d;
    if (slot < 52) return 3078 + 64 * (slot - 48) + d;
    if (slot == 52) return 3334 + d;
    if (slot == 53) { if (d < 6) return 1152 + d; if (d >= 8 && d < 12) return 3398 + (d - 8); return -1; }
    return -1;
}
struct CvtJob { const float* W; const float* W2; int ldw; int K; int N; bf16* dst; int dld; int koff; const float* gain; int cmode; };
__device__ __forceinline__ void cvt_item(const CvtJob& J, int item, LAS float* scr, int lane) {
    const int nblk = J.N / 32, kb = item / nblk, nb = item % nblk, k0 = 64 * kb, n0 = 32 * nb;
    const int p = n0 + (lane & 31);
    const float* src = J.W; int col = p;
    if (J.cmode == 1) { src = ((p >> 7) & 1) ? J.W2 : J.W; col = 128 * (p >> 8) + (p & 127); }
    else if (J.cmode == 2) { col = win_src_col(p); }
    float v[32];
    const float* sp = src + (size_t)(k0 + (lane >> 5)) * J.ldw + (col >= 0 ? col : 0);
#pragma unroll
    for (int i = 0; i < 32; ++i) v[i] = sp[(size_t)(2 * i) * J.ldw];
    if (J.gain) { const float* gp = J.gain + k0 + (lane >> 5);
#pragma unroll
        for (int i = 0; i < 32; ++i) v[i] *= gp[2 * i]; }
    if (col < 0) {
#pragma unroll
        for (int i = 0; i < 32; ++i) v[i] = 0.f; }
#pragma unroll
    for (int i = 0; i < 32; ++i) scr[(2 * i + (lane >> 5)) * 33 + (lane & 31)] = v[i];
    asm volatile("s_waitcnt lgkmcnt(0)" ::: "memory");
    const int c = lane & 7;
#pragma unroll
    for (int j = 0; j < 4; ++j) { const int n = (lane >> 3) + 8 * j; const LAS float* s = scr + (8 * c) * 33 + n;
        u32x4 o; o.x = cvtpk(s[0 * 33], s[1 * 33]); o.y = cvtpk(s[2 * 33], s[3 * 33]); o.z = cvtpk(s[4 * 33], s[5 * 33]); o.w = cvtpk(s[6 * 33], s[7 * 33]);
        *(u32x4*)(J.dst + (size_t)(n0 + n) * J.dld + J.koff + k0 + 8 * c) = o; }
    asm volatile("s_waitcnt lgkmcnt(0)" ::: "memory");
}

struct Args { const float* in[24]; float* out; unsigned char* ws; };

template <int NN>
struct UpSched {
    pg8::TileOrder<M / 256, NN> T; unsigned wb;
    __device__ bool get(int i, pg8::GUnit& u) const { int pm, pn; if (!T.tile(i, pm, pn)) return false;
        u.a = (unsigned)WS_XB + (unsigned)pm * (256 * 2048); u.b = wb + (unsigned)pn * (256 * 2048); u.lda = 2048; u.ldb = 2048; u.nt = 16; u.pm = pm; u.pn = pn; u.mode = 0; u.ui = i; return true; }
};
struct DownSched {
    pg8::TileOrder<M / 256, 4> T; unsigned wb;
    __device__ bool get(int i, pg8::GUnit& u) const { int pm, pn; if (!T.tile(i, pm, pn)) return false;
        u.a = (unsigned)WS_ACT + (unsigned)pm * (256 * DFF * 2); u.b = wb + (unsigned)pn * (256 * DFF * 2); u.lda = DFF * 2; u.ldb = DFF * 2; u.nt = DFF / 64; u.pm = pm; u.pn = pn; u.mode = 0; return true; }
};
struct WoutSched {
    pg8::TileOrder<M / 256, 4> T; unsigned wb;
    __device__ bool get(int i, pg8::GUnit& u) const { int pm, pn; if (!T.tile(i, pm, pn)) return false;
        u.a = (unsigned)WS_ACT + SL_MERGED * 128 + (unsigned)pm * (256 * ACTP * 2); u.b = wb + (unsigned)pn * (256 * 2048); u.lda = ACTP * 2; u.ldb = 2048; u.nt = 16; u.pm = pm; u.pn = pn; u.mode = 0; return true; }
};
struct MergeSched {
    pg8::TileOrder<M / 256, 4> T; unsigned wbr;
    __device__ bool get(int i, pg8::GUnit& u) const { int pm, pn; if (!T.tile(i / 3, pm, pn)) return false;
        const int x = i % 3; u.pm = pm; u.pn = pn; u.mode = x; u.ldb = 2048;
        const unsigned ko = x == 0 ? 0 : x == 1 ? 384 : 768;
        u.a = (unsigned)WS_ACT + (unsigned)pm * (256 * ACTP * 2) + ko * 2; u.lda = ACTP * 2; u.b = wbr + (unsigned)(pn * 256) * 2048 + ko * 2; u.nt = x == 2 ? 4 : 6;
        return true; }
};

__device__ __forceinline__ int q_pop(gu32* ctr, volatile LAS unsigned* slot) {
    __syncthreads();
    if (otid() == 0) *slot = __hip_atomic_fetch_add(ctr, 1u, RLX_AGENT);
    __syncthreads();
    return (int)*slot;
}

__global__ void __launch_bounds__(512, 2) mega_fwd(Args args) {
    extern __shared__ __attribute__((aligned(16))) unsigned char lds_raw[];
    LAS unsigned char* lds = (LAS unsigned char*)lds_raw;
    volatile LAS unsigned* MISC = (volatile LAS unsigned*)(lds + MISC_OFF);
    {
        const int t0 = threadIdx.x;
        if (t0 < (LDS_BYTES - MISC_OFF) / 4) ((LAS unsigned*)(lds + MISC_OFF))[t0] = 0u;
        __syncthreads();
        if ((t0 & 63) == 0) ((LAS int*)(lds + TIDMAP_OFF))[(unsigned)__builtin_amdgcn_s_getreg((5 << 11) | 4)] = t0 >> 6;
        if (t0 == 0) {
#pragma unroll
            for (int i = 0; i < 24; ++i) ((LAS unsigned long long*)(lds + ARGTAB_OFF))[i] = (unsigned long long)args.in[i];
            ((LAS unsigned long long*)(lds + ARGTAB_OFF))[24] = (unsigned long long)args.out;
        }
        __syncthreads();
    }
    int tid = otid();
    const int lane = tid & 63, wave = __builtin_amdgcn_readfirstlane(tid >> 6);
    const int G = gridDim.x; const int bx = blockIdx.x;
    const int vcu = (G % 8 == 0) ? (bx % 8) * (G / 8) + bx / 8 : bx;
    unsigned char* ws = args.ws;
    gu32* ctl = (gu32*)(ws + WS_CTL);
    XcdBarrier bar = xcd_barrier_post((unsigned*)(ctl + CW_BAR), MISC + 8);

    bf16* XB = (bf16*)(ws + WS_XB); float* SSP = (float*)(ws + WS_SSP); float* LOGF = (float*)(ws + WS_LOGF); float* WI = (float*)(ws + WS_WI);
    unsigned* MASKW = (unsigned*)(ws + WS_MASK); bf16* ACT = (bf16*)(ws + WS_ACT); const bf16* KVH = (const bf16*)(ws + WS_KVH);
    const float* x_in = arg_in(0);

    for (int rep0 = 0; rep0 < ((PROBE == 10) ? 2 : 1); ++rep0) {
        LAS float* scr = (LAS float*)(lds + wave * 16384);
        const int gw = vcu * 8 + wave, NGW = G * 8;
        {
            const int gt = bx * 512 + tid, NGT = G * 512;
            float* par = (float*)(ws + WS_PAR);
            for (int i = gt; i < DEPTH * 4096; i += NGT) {
                const int l = i >> 12, k = i & 4095; float v = 0.f;
                if (k < 384) v = arg_in(10 + (k >> 6))[l * 64 + (k & 63)];
                else if (k < 390) v = arg_in(8)[l * 6 + (k - 384)];
                else if (k == 390) {
                    const f32x4* g10 = (const f32x4*)(arg_in(10) + l * 64); const f32x4* g11 = (const f32x4*)(arg_in(11) + l * 64);
                    f32x4 a4[16], b4[16];
#pragma unroll
                    for (int d = 0; d < 16; ++d) { a4[d] = g10[d]; b4[d] = g11[d]; }
                    float gq = 0.f, gk = 0.f;
#pragma unroll
                    for (int d = 0; d < 16; ++d) { gq = fmaxf(fmaxf(gq, fmaxf(fabsf(a4[d][0]), fabsf(a4[d][1]))), fmaxf(fabsf(a4[d][2]), fabsf(a4[d][3]))); gk = fmaxf(fmaxf(gk, fmaxf(fabsf(b4[d][0]), fabsf(b4[d][1]))), fmaxf(fabsf(b4[d][2]), fabsf(b4[d][3]))); }
                    v = 64.0f * C2 * gq * gk * 1.02f; }
                else if (k == 391) {
                    const f32x4* g14 = (const f32x4*)(arg_in(14) + l * 64); const f32x4* g15 = (const f32x4*)(arg_in(15) + l * 64);
                    f32x4 a4[16], b4[16];
#pragma unroll
                    for (int d = 0; d < 16; ++d) { a4[d] = g14[d]; b4[d] = g15[d]; }
                    float gq = 0.f, gk = 0.f;
#pragma unroll
                    for (int d = 0; d < 16; ++d) { gq = fmaxf(fmaxf(gq, fmaxf(fabsf(a4[d][0]), fabsf(a4[d][1]))), fmaxf(fabsf(a4[d][2]), fabsf(a4[d][3]))); gk = fmaxf(fmaxf(gk, fmaxf(fabsf(b4[d][0]), fabsf(b4[d][1]))), fmaxf(fabsf(b4[d][2]), fabsf(b4[d][3]))); }
                    v = 64.0f * C2 * gq * gk * 1.02f; }
                else if (k >= 512 && k < 512 + 3 * DM) v = arg_in(9)[l * 3 * DM + (k - 512)];
                par[i] = v;
            }
            int* posd = (int*)(ws + WS_POS); const int* poss = (const int*)arg_in(1);
            for (int i = gt; i < M; i += NGT) posd[i] = poss[i];
        }
        for (int m0 = gw; m0 < M; m0 += 2 * NGW) {
            f32x4 v[2][4];
#pragma unroll
            for (int r = 0; r < 2; ++r) { const int m = m0 + r * NGW; if (m < M) { const GAS f32x4* xr = (const GAS f32x4*)(x_in + (size_t)m * DM) + lane;
#pragma unroll
                for (int j = 0; j < 4; ++j) v[r][j] = xr[64 * j]; } }
#pragma unroll
            for (int r = 0; r < 2; ++r) { const int m = m0 + r * NGW; if (m < M) {
                float s = 0.f;
                GAS u32x2* o8 = (GAS u32x2*)(XB + (size_t)m * DM) + lane;
#pragma unroll
                for (int j = 0; j < 4; ++j) { u32x2 w; w.x = cvtpk(v[r][j][0], v[r][j][1]); w.y = cvtpk(v[r][j][2], v[r][j][3]); o8[64 * j] = w;
                    const float r0 = bflo(w.x), r1 = bfhi(w.x), r2 = bflo(w.y), r3 = bfhi(w.y); s += (r0 * r0 + r1 * r1) + (r2 * r2 + r3 * r3); }
                s = wave_sum(s);
                if (lane < 16) SSP[(size_t)m * 16 + lane] = lane == 0 ? s : 0.f; } }
        }
    }

    constexpr int CV_P9 = 2816 + 1408 + 1792 + 1536 + 192 + 192 + 128 + 512 + 2816, CV_PT = CV_P9 + 1408;
    auto convert = [&](const int l, const int g0, const int g1) {
            int tid_c = otid();
            const int lane_c = tid_c & 63, wave_c = __builtin_amdgcn_readfirstlane(tid_c >> 6);
            LAS float* scr = (LAS float*)(lds + wave_c * 16384);
            const int gw = vcu * 8 + wave_c, NGW = G * 8;
            unsigned char* wl = ws + WS_W;
            constexpr int NI0 = 2816, NI1 = 1408, NI2 = 1792, NI3 = 1536, NI4 = 192, NI5 = 192, NI6 = 128, NI7 = 512, NI8 = 2816, NI9 = 1408;
            constexpr int P1 = NI0, P2 = P1 + NI1, P3 = P2 + NI2, P4 = P3 + NI3, P5 = P4 + NI4, P6 = P5 + NI5, P7 = P6 + NI6, P8 = P7 + NI7, P9 = P8 + NI8, PT = P9 + NI9;
            static_assert(NI0 == (DM / 64) * (2 * DFF / 32) && NI1 == (DFF / 64) * (DM / 32) && NI2 == (DM / 64) * (NWIN / 32) && NI3 == (DM / 64) * (3 * DM / 32) && NI4 == (384 / 64) * (DM / 32) && NI6 == (256 / 64) * (DM / 32) && NI7 == (DM / 64) * (DM / 32), "conversion item counts");
            for (int g = g0 + gw; g < g1; g += NGW) {
                const int j = g < P1 ? 0 : g < P2 ? 1 : g < P3 ? 2 : g < P4 ? 3 : g < P5 ? 4 : g < P6 ? 5 : g < P7 ? 6 : g < P8 ? 7 : g < P9 ? 8 : 9;
                int it = g;
                CvtJob J; J.W2 = nullptr; J.gain = nullptr; J.koff = 0; J.cmode = 0;
                switch (j) {
                case 0: J.W = arg_in(3) + (size_t)l * DM * DFF; J.W2 = arg_in(4) + (size_t)l * DM * DFF; J.ldw = DFF; J.K = DM; J.N = 2 * DFF; J.dst = (bf16*)(wl + W_GU); J.dld = DM; J.gain = arg_in(2) + l * DM; J.cmode = 1; break;
                case 1: it -= P1; J.W = arg_in(5) + (size_t)l * DFF * DM; J.ldw = DM; J.K = DFF; J.N = DM; J.dst = (bf16*)(wl + W_D); J.dld = DFF; break;
                case 2: it -= P2; J.W = arg_in(7) + (size_t)l * DM * NIN; J.ldw = NIN; J.K = DM; J.N = NWIN; J.dst = (bf16*)(wl + W_IN); J.dld = DM; J.gain = arg_in(6) + l * DM; J.cmode = 2; break;
                case 3: it -= P3; J.W = arg_in(7) + (size_t)l * DM * NIN + 3402; J.ldw = NIN; J.K = DM; J.N = 3 * DM; J.dst = (bf16*)(wl + W_G); J.dld = DM; J.gain = arg_in(6) + l * DM; break;
                case 4: it -= P4; J.W = arg_in(16) + (size_t)l * 384 * DM; J.ldw = DM; J.K = 384; J.N = DM; J.dst = (bf16*)(wl + W_BR); J.dld = DM; J.koff = 0; break;
                case 5: it -= P5; J.W = arg_in(17) + (size_t)l * 384 * DM; J.ldw = DM; J.K = 384; J.N = DM; J.dst = (bf16*)(wl + W_BR); J.dld = DM; J.koff = 384; break;
                case 6: it -= P6; J.W = arg_in(18) + (size_t)l * 256 * DM; J.ldw = DM; J.K = 256; J.N = DM; J.dst = (bf16*)(wl + W_BR); J.dld = DM; J.koff = 768; break;
                case 7: it -= P7; J.W = arg_in(19) + (size_t)l * DM * DM; J.ldw = DM; J.K = DM; J.N = DM; J.dst = (bf16*)(wl + W_OUT); J.dld = DM; break;
                case 8: it -= P8; J.W = arg_in(21) + (size_t)l * DM * DFF; J.W2 = arg_in(22) + (size_t)l * DM * DFF; J.ldw = DFF; J.K = DM; J.N = 2 * DFF; J.dst = (bf16*)(wl + W_GU2); J.dld = DM; J.gain = arg_in(20) + l * DM; J.cmode = 1; break;
                default: it -= P9; J.W = arg_in(23) + (size_t)l * DFF * DM; J.ldw = DM; J.K = DFF; J.N = DM; J.dst = (bf16*)(wl + W_D2); J.dld = DFF; break;
                }
                cvt_item(J, it, scr, lane_c);
            }
        };
    convert(0, 0, CV_PT);
    for (int l = 0; l < DEPTH; ++l) {
        const unsigned wl = (unsigned)WS_W;
        xcd_barrier(bar);
        if (l > 0) convert(l, CV_P9, CV_PT);
#define OBX() ({ int _b = blockIdx.x; asm volatile("" : "+s"(_b)); _b; })
#define NREP(k) ((PROBE == (k)) ? 2 : 1)
        for (int rep = 0; rep < NREP(1); ++rep) {
            UpSched<22> S; S.T.init(G, OBX()); S.wb = wl + (unsigned)W_GU;
            pg8::EpiUp E{ws};
            pg8::rowq_table(lds, ws, S);
            pg8::gemm_phase(lds, ws, S, E);
            xcd_barrier(bar);
        }
        for (int rep = 0; rep < NREP(2); ++rep) {
            DownSched S; S.T.init(G, OBX()); S.wb = wl + (unsigned)W_D;
            pg8::EpiRes E{ws, nullptr, rep == NREP(2) - 1 ? 0.5f : 0.0f};
            pg8::gemm_phase(lds, ws, S, E);
            xcd_barrier(bar);
        }
        for (int rep = 0; rep < NREP(3); ++rep) {
            UpSched<26> S; S.T.init(G, OBX()); S.wb = wl + (unsigned)W_IN;
            pg8::EpiWin E{ws, l};
            pg8::rowq_table(lds, ws, S);
            pg8::gemm_phase(lds, ws, S, E);
            xcd_barrier(bar);
        }
        asm volatile(".rept 1\n\ts_nop 0\n\t.endr");
        for (int rep = 0; rep < NREP(4); ++rep) {
            gu32* qc = ctl + CW_Q + 64 * (l * 8 + 0 + 4 * rep);
            for (int u = q_pop(qc, MISC + 16); u < 512; u = (int)MISC[17]) {
                const int qi = 63 - (u >> 3), b = u & 7;
                att::select_unit(b, qi, ACT, KVH, WI, MASKW + (size_t)b * 64 * SEQ * 2, (LAS char*)lds, qc, MISC + 17, ctl + CW_RDY + l * 16);
            }
            if (rep + 1 < NREP(4)) xcd_barrier(bar);
        }
        for (int rep = 0; rep < NREP(5); ++rep) {
            gu32* qc = ctl + CW_Q + 64 * (l * 8 + 1 + 4 * rep);
            const bool real = rep == NREP(5) - 1;
            for (int u = q_pop(qc, MISC + 16); u < 768; u = (int)MISC[17]) {
                const int qb = 15 - u / 48, bh = u % 48, b = bh / 6, h = bh % 6;
                const float bnd = __builtin_bit_cast(float, __builtin_amdgcn_readfirstlane(__builtin_bit_cast(int, ((const float*)(ws + WS_PAR))[l * 4096 + 390])));
                if (bnd <= 40.0f) att::attn_unit_x<att::A_FOX, 8, true>(b, SL_FQ + h, KV_FK + h, KV_FV + h, real ? SL_FQ + h : 35, qb, ACT, KVH, LOGF + (size_t)bh * SEQ, nullptr, bnd, (LAS char*)lds, qc, MISC + 17);
                else att::attn_unit_x<att::A_FOX, 8, false>(b, SL_FQ + h, KV_FK + h, KV_FV + h, real ? SL_FQ + h : 35, qb, ACT, KVH, LOGF + (size_t)bh * SEQ, nullptr, bnd, (LAS char*)lds, qc, MISC + 17);
            }
            if (rep + 1 < NREP(5)) xcd_barrier(bar);
        }
        for (int rep = 0; rep < NREP(6); ++rep) {
            gu32* qc = ctl + CW_Q + 64 * (l * 8 + 2 + 4 * rep);
            const bool real = rep == NREP(6) - 1;
            {
                if (otid() == 0) {
                    gu32* rdy = ctl + CW_RDY + l * 16;
                    unsigned sp_ = 0u;
                    while (__hip_atomic_load(rdy, RLX_AGENT) < 512u && ++sp_ < (1u << 22)) __builtin_amdgcn_s_sleep(1);
                    __builtin_amdgcn_fence(__ATOMIC_ACQUIRE, "agent");
                    asm volatile("s_waitcnt vmcnt(0)" ::: "memory");
                }
                __syncthreads();
            }
            for (int u = q_pop(qc, MISC + 16); u < 512; u = (int)MISC[17]) {
                const int qb = 15 - u / 32, bh = u % 32, b = bh / 4, h = bh % 4;
                const float bnd = __builtin_bit_cast(float, __builtin_amdgcn_readfirstlane(__builtin_bit_cast(int, ((const float*)(ws + WS_PAR))[l * 4096 + 391])));
                if (bnd <= 40.0f) att::attn_unit_x<att::A_DSA, 8, true>(b, SL_CQ + h, KV_CK + h, KV_CV + h, real ? SL_CQ + h : 35, qb, ACT, KVH, nullptr, MASKW + (size_t)b * 64 * SEQ * 2, bnd, (LAS char*)lds, qc, MISC + 17);
                else att::attn_unit_x<att::A_DSA, 8, false>(b, SL_CQ + h, KV_CK + h, KV_CV + h, real ? SL_CQ + h : 35, qb, ACT, KVH, nullptr, MASKW + (size_t)b * 64 * SEQ * 2, bnd, (LAS char*)lds, qc, MISC + 17);
            }
            if (rep + 1 < NREP(6)) xcd_barrier(bar);
        }
        for (int rep = 0; rep < NREP(7); ++rep) {
            gu32* qc = ctl + CW_Q + 64 * (l * 8 + 3 + 4 * rep);
            const bool real = rep == NREP(7) - 1;
            for (int u = q_pop(qc, MISC + 16); u < 768; u = (int)MISC[17]) {
                const int qb = 15 - u / 48, bh = u % 48, b = bh / 6, h = bh % 6;
                att::attn_unit<att::A_SB>(b, SL_SQ + h, KV_SK + h, KV_SV + h, real ? SL_SQ + h : 35, qb, ACT, KVH, nullptr, nullptr, 0.f, (LAS char*)lds, qc, MISC + 17);
            }
            xcd_barrier(bar);
        }
        for (int rep = 0; rep < NREP(8); ++rep) {
            MergeSched S; S.T.init(G, OBX()); S.wbr = wl + (unsigned)W_BR;
            pg8::EpiMerge E{ws};
            pg8::gemm_phase(lds, ws, S, E);
            xcd_barrier(bar);
        }
        for (int rep = 0; rep < NREP(9); ++rep) {
            WoutSched S; S.T.init(G, OBX()); S.wb = wl + (unsigned)W_OUT;
            pg8::EpiRes E{ws, nullptr, rep == NREP(9) - 1 ? 1.0f : 0.0f};
            pg8::gemm_phase(lds, ws, S, E);
            xcd_barrier(bar);
        }
        {
            UpSched<22> S; S.T.init(G, OBX()); S.wb = wl + (unsigned)W_GU2;
            pg8::EpiUp E{ws};
            pg8::rowq_table(lds, ws, S);
            pg8::gemm_phase(lds, ws, S, E);
        }
        xcd_barrier(bar);
        {
            DownSched S; S.T.init(G, OBX()); S.wb = wl + (unsigned)W_D2;
            pg8::EpiRes E{ws, l + 1 == DEPTH ? (float*)arg_in(24) : nullptr, 0.5f};
            pg8::gemm_phase(lds, ws, S, E);
        }
        if (l + 1 < DEPTH) convert(l + 1, 0, CV_P9);
    }
}

extern "C" void kernel_launch(void* const* d_in, const int* in_sizes, int n_in, void* d_out, int out_size, void* d_ws, size_t ws_size, hipStream_t stream) {
    static int grid = 0;
    if (grid == 0) {
        if (n_in != 24 || out_size != M * DM || ws_size < WS_END) { fprintf(stderr, "kernel_launch: unexpected shapes (n_in %d out %d ws %zu, need %zu)\n", n_in, out_size, ws_size, (size_t)WS_END); grid = -1; return; }
        int dev = 0, cus = 0, per_cu = 0;
        if (hipGetDevice(&dev) != hipSuccess || hipDeviceGetAttribute(&cus, hipDeviceAttributeMultiprocessorCount, dev) != hipSuccess) { grid = -1; return; }
        if (hipFuncSetAttribute((const void*)mega_fwd, hipFuncAttributeMaxDynamicSharedMemorySize, LDS_BYTES) != hipSuccess) { fprintf(stderr, "kernel_launch: hipFuncSetAttribute failed\n"); grid = -1; return; }
        if (hipOccupancyMaxActiveBlocksPerMultiprocessor(&per_cu, (const void*)mega_fwd, 512, LDS_BYTES) != hipSuccess || per_cu < 1) { fprintf(stderr, "kernel_launch: occupancy query says %d\n", per_cu); }
        (void)hipGetLastError();
        grid = cus;
    }
    if (grid < 0) return;
    if (hipMemsetAsync((char*)d_ws + WS_CTL, 0, CTL_CLEAR, stream) != hipSuccess) return;
    Args a{};
    for (int i = 0; i < 24; ++i) a.in[i] = (const float*)d_in[i];
    a.out = (float*)d_out; a.ws = (unsigned char*)d_ws;
    hipLaunchKernelGGL(mega_fwd, dim3(grid), dim3(512), LDS_BYTES, stream, a);
}
```
